# Optimizing an MI355X kernel written in HIP

```python
import jax, jax.numpy as jnp
from jax import lax
import numpy as np

D_MODEL = 1024
BATCH = 16
SEQ = 2048
DEPTH = 1

CHUNK = 128
MIX_WIDTH = D_MODEL
GMLP_WIDTH = MIX_WIDTH // 2
GMLP_GROUP_DIM = 128
N_GMLP_GROUPS = GMLP_WIDTH // GMLP_GROUP_DIM
RET_WIDTH = MIX_WIDTH - GMLP_WIDTH
RET_HEAD_DIM = 128
N_RET_HEADS = RET_WIDTH // RET_HEAD_DIM
ROPE_THETA = 10000.0
EPS = 1e-6
PROJ_SIZES = [GMLP_WIDTH, GMLP_WIDTH, GMLP_WIDTH, RET_WIDTH, RET_WIDTH, RET_WIDTH, RET_WIDTH]
PROJ_WIDTH = sum(PROJ_SIZES)
PROJ_SPLITS = [int(i) for i in np.cumsum(PROJ_SIZES)[:-1]]

kernel_name = "hybrid_gmlp_retention_adaln_block"


def rmsnorm(x, g):
    xf = x.astype(jnp.float32)
    y = xf * lax.rsqrt(jnp.mean(xf * xf, axis=-1, keepdims=True) + EPS)
    return (y * g.astype(jnp.float32)).astype(x.dtype)


def group_layernorm(x, g):
    xf = x.astype(jnp.float32)
    mu = jnp.mean(xf, axis=-1, keepdims=True)
    var = jnp.mean(jnp.square(xf - mu), axis=-1, keepdims=True)
    return ((xf - mu) * lax.rsqrt(var + EPS) * g.astype(jnp.float32)).astype(x.dtype)


def rotary(x, positions):
    half = x.shape[-1] // 2
    inv_freq = 1.0 / (ROPE_THETA ** (jnp.arange(half, dtype=jnp.float32) / half))
    ang = positions.astype(jnp.float32)[..., None] * inv_freq
    cos = jnp.cos(ang)[:, :, None, :].astype(x.dtype)
    sin = jnp.sin(ang)[:, :, None, :].astype(x.dtype)
    x1, x2 = x[..., :half], x[..., half:]
    return jnp.concatenate([x1 * cos - x2 * sin, x2 * cos + x1 * sin], axis=-1)


def gmlp_branch(u, v, gate, ln_g, w_s, b_s):
    B, S, _ = u.shape
    nc = S // CHUNK
    v = v.reshape(B, nc, CHUNK, N_GMLP_GROUPS, GMLP_GROUP_DIM)
    v = group_layernorm(v, ln_g.reshape(N_GMLP_GROUPS, GMLP_GROUP_DIM))
    causal = jnp.tril(jnp.ones((CHUNK, CHUNK), dtype=w_s.dtype))
    ws = w_s * causal[None]
    mixed = jnp.einsum('gts,bnsgd->bntgd', ws, v) + b_s.T[None, None, :, :, None]
    out = u.reshape(B, nc, CHUNK, N_GMLP_GROUPS, GMLP_GROUP_DIM) * mixed
    return out.reshape(B, S, GMLP_WIDTH) * jax.nn.silu(gate)


def retention_branch(q, k, v, gate, positions, gn_g):
    B, S, _ = q.shape
    nc = S // CHUNK
    H, Dh = N_RET_HEADS, RET_HEAD_DIM
    q = rotary(q.reshape(B, S, H, Dh), positions)
    k = rotary(k.reshape(B, S, H, Dh), positions) * (Dh ** -0.5)
    v = v.reshape(B, S, H, Dh)
    q = q.reshape(B, nc, CHUNK, H, Dh)
    k = k.reshape(B, nc, CHUNK, H, Dh)
    v = v.reshape(B, nc, CHUNK, H, Dh)

    log_gamma = jnp.log(1.0 - 2.0 ** (-5.0 - jnp.arange(H, dtype=jnp.float32)))
    idx = jnp.arange(CHUNK, dtype=jnp.float32)
    diff = idx[:, None] - idx[None, :]
    decay_mask = jnp.where(diff[None] >= 0,
                           jnp.exp(jnp.maximum(diff, 0.0)[None] * log_gamma[:, None, None]),
                           0.0)

    scores = jnp.einsum('bnqhd,bnkhd->bnhqk', q, k) * decay_mask[None, None]
    intra = jnp.einsum('bnhqk,bnkhe->bnqhe', scores, v)

    k_decay = jnp.exp((CHUNK - 1.0 - idx)[:, None] * log_gamma[None, :])
    kv_chunk = jnp.einsum('bnkhd,bnkhe,kh->bnhde', k, v, k_decay)
    chunk_decay = jnp.exp(CHUNK * log_gamma)[None, :, None, None]

    def step(state, kv):
        return state * chunk_decay + kv, state

    init = jnp.zeros_like(kv_chunk[:, 0])
    _, states = lax.scan(step, init, jnp.moveaxis(kv_chunk, 1, 0))
    states = jnp.moveaxis(states, 0, 1)

    q_decay = jnp.exp((idx + 1.0)[:, None] * log_gamma[None, :])
    cross = jnp.einsum('bnqhd,bnhde,qh->bnqhe', q, states, q_decay)

    o = (intra + cross).reshape(B, S, H, Dh)
    o = group_layernorm(o, gn_g.reshape(H, Dh)).astype(gate.dtype)
    return o.reshape(B, S, RET_WIDTH) * jax.nn.silu(gate)


def hybrid_layer(x, c, positions, w_ada, b_ada, g_pre, w_in, gmlp_ln_g, gmlp_ws, gmlp_bs,
                 ret_gn_g, w_out, g_post):
    mod = jnp.einsum('bd,de->be', jax.nn.silu(c), w_ada) + b_ada
    shift, scale, gate = jnp.split(mod, 3, axis=-1)
    h = rmsnorm(x, g_pre) * (1.0 + scale[:, None, :]) + shift[:, None, :]
    proj = jnp.einsum('bsd,de->bse', h, w_in)
    gu, gv, gg, rq, rk, rv, rg = jnp.split(proj, PROJ_SPLITS, axis=-1)
    y_gmlp = gmlp_branch(gu, gv, gg, gmlp_ln_g, gmlp_ws, gmlp_bs)
    y_ret = retention_branch(rq, rk, rv, rg, positions, ret_gn_g)
    y = jnp.concatenate([y_gmlp, y_ret], axis=-1)
    y = rmsnorm(jnp.einsum('bsm,md->bsd', y, w_out), g_post)
    return x + gate[:, None, :] * y


def setup_inputs(seed: int = 0) -> dict:
    key = jax.random.key(seed)
    ks = jax.random.split(key, 14)
    f32 = jnp.float32
    x = jax.random.normal(ks[0], (BATCH, SEQ, D_MODEL), f32)
    c = jax.random.normal(ks[1], (BATCH, D_MODEL), f32)
    positions = jnp.broadcast_to(jnp.arange(SEQ, dtype=jnp.int32)[None, :], (BATCH, SEQ))
    w_ada = jax.random.normal(ks[2], (DEPTH, D_MODEL, 3 * D_MODEL), f32) * (0.5 * D_MODEL ** -0.5)
    b_ada = jax.random.normal(ks[3], (DEPTH, 3 * D_MODEL), f32) * 0.02
    g_pre = 1.0 + 0.02 * jax.random.normal(ks[4], (DEPTH, D_MODEL), f32)
    w_in = jax.random.normal(ks[5], (DEPTH, D_MODEL, PROJ_WIDTH), f32) * (D_MODEL ** -0.5)
    gmlp_ln_g = 1.0 + 0.02 * jax.random.normal(ks[6], (DEPTH, GMLP_WIDTH), f32)
    gmlp_ws = jax.random.normal(ks[7], (DEPTH, N_GMLP_GROUPS, CHUNK, CHUNK), f32) * (CHUNK ** -0.5)
    gmlp_bs = 1.0 + 0.02 * jax.random.normal(ks[8], (DEPTH, N_GMLP_GROUPS, CHUNK), f32)
    ret_gn_g = 1.0 + 0.02 * jax.random.normal(ks[9], (DEPTH, RET_WIDTH), f32)
    w_out = jax.random.normal(ks[10], (DEPTH, MIX_WIDTH, D_MODEL), f32) * (MIX_WIDTH ** -0.5)
    g_post = 1.0 + 0.02 * jax.random.normal(ks[11], (DEPTH, D_MODEL), f32)
    return {"x": x, "c": c, "positions": positions, "w_ada": w_ada, "b_ada": b_ada,
            "g_pre": g_pre, "w_in": w_in, "gmlp_ln_g": gmlp_ln_g, "gmlp_ws": gmlp_ws,
            "gmlp_bs": gmlp_bs, "ret_gn_g": ret_gn_g, "w_out": w_out, "g_post": g_post}


def reference(x, c, positions, w_ada, b_ada, g_pre, w_in, gmlp_ln_g, gmlp_ws, gmlp_bs,
              ret_gn_g, w_out, g_post):
    for layer in range(DEPTH):
        x = hybrid_layer(x, c, positions, w_ada[layer], b_ada[layer], g_pre[layer], w_in[layer],
                         gmlp_ln_g[layer], gmlp_ws[layer], gmlp_bs[layer], ret_gn_g[layer],
                         w_out[layer], g_post[layer])
    return x
```

```cpp
#include <hip/hip_runtime.h>
#include <stdint.h>
#include <stdio.h>

typedef __attribute__((ext_vector_type(8))) short bf16x8;
typedef __attribute__((ext_vector_type(4))) float f32x4;
typedef unsigned short u16;
#define DEVFN __device__ __forceinline__
#define NTHREADS 512
#define LAS __attribute__((address_space(3)))

#define OFF_BAR    0ull
#define OFF_MOD    16384ull
#define OFF_WINF   262144ull
#define OFF_WOUTF  7602176ull
#define OFF_WS     9699328ull
#define OFF_H      16777216ull
#define OFF_Y      83886080ull
#define OFF_QD     150994944ull
#define OFF_SG     184549376ull
#define OFF_INTRA  218103808ull
#define OFF_KV     285212672ull
#define OFF_ST     352321536ull

#define SM_SMALL   139264
#define SM_BARW    147456
#define SM_TOTAL   (147456 + 16)

struct P {
    const float* x; const float* c; const int* pos; const float* w_ada; const float* b_ada; const float* g_pre;
    const float* w_in; const float* ln_g; const float* gws; const float* gbs; const float* gn_g; const float* w_out;
    const float* g_post; float* out; char* ws;
    int ph_lo, ph_hi;
};

DEVFN u16 f2bf(float f) {
    uint32_t u = __float_as_uint(f);
    u += 0x7fffu + ((u >> 16) & 1u);
    return (u16)(u >> 16);
}
DEVFN float bf2f(u16 h) { return __uint_as_float(((uint32_t)h) << 16); }
DEVFN uint32_t pack2(float a, float b) { return (uint32_t)f2bf(a) | ((uint32_t)f2bf(b) << 16); }
DEVFN uint2 pack4(float a, float b, float c, float d) { uint2 r; r.x = pack2(a, b); r.y = pack2(c, d); return r; }
DEVFN float silu(float x) { return x / (1.0f + __expf(-x)); }
DEVFN int swz(int row, int chunk) { return row * 256 + ((chunk ^ (row & 15)) << 4); }
DEVFN bf16x8 frag(const char* base, int tile, int ks, int fr, int fq) {
    return *(const bf16x8*)(base + swz(tile * 16 + fr, ks * 4 + fq));
}
DEVFN f32x4 mfma16(bf16x8 a, bf16x8 b, f32x4 c) { return __builtin_amdgcn_mfma_f32_16x16x32_bf16(a, b, c, 0, 0, 0); }

#define XB_TMO      128
#define XB_XCNT(j)  (256  + 64 * (j))
#define XB_XSUB(j)  (1280 + 64 * (j))
#define XB_XGEN(j)  (2304 + 64 * (j))
#define XB_TOP      3328
#define XB_TOPGEN   3392
#define XCD_BAR_WORDS 3456
#define XB_SPIN_CAP (1u << 22)
DEVFN unsigned xb_ld(unsigned* p) { return __hip_atomic_load(p, __ATOMIC_RELAXED, __HIP_MEMORY_SCOPE_AGENT); }
DEVFN unsigned xb_add(unsigned* p, unsigned v) { return __hip_atomic_fetch_add(p, v, __ATOMIC_RELAXED, __HIP_MEMORY_SCOPE_AGENT); }
DEVFN unsigned xb_xcc_id() { return (unsigned)__builtin_amdgcn_s_getreg((3 << 11) | 20) & 0xFu; }
#define XB_SPIN(cond, bar) do { unsigned _sp = 0; while (cond) { __builtin_amdgcn_s_sleep(1); \
    if ((++_sp & 255u) == 0u) { if (xb_ld(&(bar)[XB_TMO])) break; if (_sp > XB_SPIN_CAP) { atomicAdd(&(bar)[XB_TMO], 1u); break; } } } } while (0)
struct XcdBarrier { unsigned* bar; unsigned x; volatile LAS unsigned* st; };
DEVFN XcdBarrier xcd_barrier_post(unsigned* bar, volatile LAS unsigned* st) {
    XcdBarrier b; b.bar = bar; b.x = xb_xcc_id(); b.st = st;
    if (threadIdx.x == 0) (void)xb_add(&bar[XB_XCNT(b.x)], 1u);
    return b;
}
DEVFN void xcd_barrier_complete(unsigned* bar, unsigned x, unsigned& nloc, unsigned& nx) {
    const unsigned G = gridDim.x * gridDim.y * gridDim.z;
    unsigned sum, cnt, mine, sp = 0u;
    for (;;) {
        sum = 0u; cnt = 0u; mine = 0u;
#pragma unroll
        for (unsigned j = 0; j < 16; ++j) { const unsigned c = xb_ld(&bar[XB_XCNT(j)]); sum += c; cnt += (c > 0u) ? 1u : 0u; mine = (j == x) ? c : mine; }
        if (sum == G) break;
        __builtin_amdgcn_s_sleep(1);
        if ((++sp & 255u) == 0u) { if (xb_ld(&bar[XB_TMO])) break; if (sp > XB_SPIN_CAP) { atomicAdd(&bar[XB_TMO], 1u); break; } }
    }
    nloc = mine > 0u ? mine : 1u; nx = cnt > 0u ? cnt : 1u;
}
DEVFN void xcd_barrier(const XcdBarrier& b) {
    asm volatile("s_waitcnt vmcnt(0)" ::: "memory");
    __syncthreads();
    if (threadIdx.x == 0) {
        unsigned* bar = b.bar;
        __builtin_amdgcn_s_waitcnt(0);
        unsigned nloc = b.st[0], nx = b.st[1];
        if (nloc == 0u) { xcd_barrier_complete(bar, b.x, nloc, nx); b.st[0] = nloc; b.st[1] = nx; }
        const unsigned old = xb_add(&bar[XB_XSUB(b.x)], 1u);
        const unsigned gen = old / nloc;
        if (old + 1u == (gen + 1u) * nloc) {
            __builtin_amdgcn_fence(__ATOMIC_RELEASE, "agent");
            asm volatile("s_waitcnt vmcnt(0)" ::: "memory");
            const unsigned og = xb_add(&bar[XB_TOP], 1u);
            const unsigned tg = og / nx;
            if (og + 1u == (tg + 1u) * nx) xb_add(&bar[XB_TOPGEN], 1u);
            else XB_SPIN(xb_ld(&bar[XB_TOPGEN]) == tg, bar);
            __builtin_amdgcn_fence(__ATOMIC_ACQUIRE, "agent");
            xb_add(&bar[XB_XGEN(b.x)], 1u);
            asm volatile("s_waitcnt vmcnt(0)" ::: "memory");
        } else {
            XB_SPIN(xb_ld(&bar[XB_XGEN(b.x)]) == gen, bar);
            __builtin_amdgcn_fence(__ATOMIC_ACQUIRE, "agent");
            asm volatile("s_waitcnt vmcnt(0)" ::: "memory");
        }
    }
    __syncthreads();
}

DEVFN int proj_feature(int j, int w, int nt, int c) {
    if (j < 4) return nt * 512 + j * 128 + w * 16 + c;
    const int hh = j - 4;
    if (w < 4) return (nt < 2 ? 1536 : 2048) + hh * 128 + (nt & 1) * 64 + w * 16 + c;
    if (w < 6) return 2560 + hh * 128 + (w - 4) * 64 + nt * 16 + c;
    return 3072 + hh * 128 + (w - 6) * 64 + nt * 16 + c;
}

DEVFN void phase0(const P& p, char* smem, int bid, int nb) {
    const int tid = threadIdx.x, lane = tid & 63, w = __builtin_amdgcn_readfirstlane(tid >> 6);
    const int N_MOD = 96, N_WIN = 896, N_WOUT = 256, N_WS = 16;
    const int NITEMS = N_MOD + N_WIN + N_WOUT + N_WS;
    for (int it = bid; it < NITEMS; it += nb) {
        if (it < N_MOD) {
            float* sc = (float*)smem;
            float* red = (float*)(smem + 65536);
            __syncthreads();
            for (int i = tid; i < 16384; i += NTHREADS) sc[i] = silu(p.c[i]);
            __syncthreads();
            const int col = tid & 31, kg = tid >> 5, e0 = it * 32;
            float acc[16];
#pragma unroll
            for (int b = 0; b < 16; ++b) acc[b] = 0.f;
#pragma unroll 4
            for (int dd = 0; dd < 64; ++dd) {
                const int d = kg * 64 + dd;
                const float wv = p.w_ada[(size_t)d * 3072 + e0 + col];
#pragma unroll
                for (int b = 0; b < 16; ++b) acc[b] += sc[b * 1024 + d] * wv;
            }
#pragma unroll
            for (int b = 0; b < 16; ++b) red[(kg * 16 + b) * 32 + col] = acc[b];
            __syncthreads();
            {
                const int b = tid >> 5;
                float s = p.b_ada[e0 + col];
#pragma unroll
                for (int k = 0; k < 16; ++k) s += red[(k * 16 + b) * 32 + col];
                ((float*)(p.ws + OFF_MOD))[b * 3072 + e0 + col] = s;
            }
        } else if (it < N_MOD + N_WIN) {
            const int F = (it - N_MOD) * 8 + w;
            int j, ww, ks, nt;
            if (F < 3072) { j = F / 768; int rem = F % 768; ww = rem / 96; int r2 = rem % 96; ks = r2 / 3; nt = r2 % 3; }
            else { int f2 = F - 3072; j = 4 + f2 / 1024; int rem = f2 % 1024; ww = rem / 128; int r2 = rem % 128; ks = r2 / 4; nt = r2 % 4; }
            const int f = proj_feature(j, ww, nt, lane & 15);
            const int k0 = ks * 32 + (lane >> 4) * 8;
            float v[8];
#pragma unroll
            for (int q = 0; q < 8; ++q) v[q] = p.w_in[(size_t)(k0 + q) * 3584 + f];
            uint4 o; o.x = pack2(v[0], v[1]); o.y = pack2(v[2], v[3]); o.z = pack2(v[4], v[5]); o.w = pack2(v[6], v[7]);
            ((uint4*)(p.ws + OFF_WINF))[(size_t)F * 64 + lane] = o;
        } else if (it < N_MOD + N_WIN + N_WOUT) {
            const int F = (it - N_MOD - N_WIN) * 8 + w;
            const int nt = F & 3, ks = (F >> 2) & 31, hw = F >> 7;
            const int n = hw * 64 + nt * 16 + (lane & 15);
            const int k0 = ks * 32 + (lane >> 4) * 8;
            float v[8];
#pragma unroll
            for (int q = 0; q < 8; ++q) v[q] = p.w_out[(size_t)(k0 + q) * 1024 + n];
            uint4 o; o.x = pack2(v[0], v[1]); o.y = pack2(v[2], v[3]); o.z = pack2(v[4], v[5]); o.w = pack2(v[6], v[7]);
            ((uint4*)(p.ws + OFF_WOUTF))[(size_t)F * 64 + lane] = o;
        } else {
            const int base = (it - N_MOD - N_WIN - N_WOUT) * 4096 + tid * 8;
            const int t = (base >> 7) & 127, s0 = base & 127;
            float v[8];
#pragma unroll
            for (int q = 0; q < 8; ++q) v[q] = (s0 + q <= t) ? p.gws[base + q] : 0.f;
            uint4 o; o.x = pack2(v[0], v[1]); o.y = pack2(v[2], v[3]); o.z = pack2(v[4], v[5]); o.w = pack2(v[6], v[7]);
            *(uint4*)((u16*)(p.ws + OFF_WS) + base) = o;
        }
    }
}

DEVFN void phase1(const P& p, int bid, int nb) {
    const int tid = threadIdx.x, lane = tid & 63, w = __builtin_amdgcn_readfirstlane(tid >> 6);
    const float* mod = (const float*)(p.ws + OFF_MOD);
    u16* H = (u16*)(p.ws + OFF_H);
    for (int rg = bid * 8 + w; rg < 2048; rg += nb * 8) {
        const int b = rg >> 7;
        float gs[16], sh[16];
#pragma unroll
        for (int i = 0; i < 4; ++i) {
            const int col = (i * 64 + lane) * 4;
            const float4 g = *(const float4*)(p.g_pre + col);
            const float4 s = *(const float4*)(mod + b * 3072 + 1024 + col);
            const float4 t = *(const float4*)(mod + b * 3072 + col);
            gs[i * 4 + 0] = g.x * (1.f + s.x); gs[i * 4 + 1] = g.y * (1.f + s.y); gs[i * 4 + 2] = g.z * (1.f + s.z); gs[i * 4 + 3] = g.w * (1.f + s.w);
            sh[i * 4 + 0] = t.x; sh[i * 4 + 1] = t.y; sh[i * 4 + 2] = t.z; sh[i * 4 + 3] = t.w;
        }
#pragma unroll 4
        for (int r = 0; r < 16; ++r) {
            const size_t row = (size_t)rg * 16 + r;
            const float4* xr = (const float4*)(p.x + row * 1024);
            float4 v[4];
#pragma unroll
            for (int i = 0; i < 4; ++i) v[i] = xr[i * 64 + lane];
            float ss = 0.f;
#pragma unroll
            for (int i = 0; i < 4; ++i) ss += v[i].x * v[i].x + v[i].y * v[i].y + v[i].z * v[i].z + v[i].w * v[i].w;
#pragma unroll
            for (int m = 32; m >= 1; m >>= 1) ss += __shfl_xor(ss, m);
            const float rs = rsqrtf(ss * (1.0f / 1024.0f) + 1e-6f);
#pragma unroll
            for (int i = 0; i < 4; ++i) {
                const uint2 o = pack4(v[i].x * rs * gs[i * 4 + 0] + sh[i * 4 + 0], v[i].y * rs * gs[i * 4 + 1] + sh[i * 4 + 1],
                                      v[i].z * rs * gs[i * 4 + 2] + sh[i * 4 + 2], v[i].w * rs * gs[i * 4 + 3] + sh[i * 4 + 3]);
                *(uint2*)(H + row * 1024 + (i * 64 + lane) * 4) = o;
            }
        }
    }
}

template <int NT>
DEVFN void gemm_core(const u16* __restrict__ A, const bf16x8* __restrict__ Bf, char* smem, f32x4 (&acc)[8][NT]) {
    int tid_ = threadIdx.x; asm volatile("" : "+v"(tid_));
    const int tid = tid_ & 511, lane = tid & 63;
    const int fr = lane & 15, fq = lane >> 4;
    const int ar = tid >> 3, ac = tid & 7;
    const char* Ab = (const char*)A;
    const char* Bb = (const char*)Bf;
    const unsigned avo = (unsigned)(ar * 2048 + ac * 16);
    const unsigned bvo = (unsigned)(lane * 16);
    const int aw = ar * 128 + ((ac ^ (ar & 7)) << 4);
    int foff[2];
    foff[0] = fr * 128 + (((0 + fq) ^ (fr & 7)) << 4);
    foff[1] = fr * 128 + (((4 + fq) ^ (fr & 7)) << 4);
#pragma unroll
    for (int mt = 0; mt < 8; ++mt)
#pragma unroll
        for (int nt = 0; nt < NT; ++nt) acc[mt][nt] = (f32x4){0.f, 0.f, 0.f, 0.f};
    uint4 a0 = *(const uint4*)(Ab + avo), a1 = *(const uint4*)(Ab + (avo + 131072u));
    bf16x8 b[2][NT];
#pragma unroll
    for (int ss = 0; ss < 2; ++ss)
#pragma unroll
        for (int nt = 0; nt < NT; ++nt) b[ss][nt] = *(const bf16x8*)(Bb + (bvo + (unsigned)((ss * NT + nt) * 1024)));
    *(uint4*)(smem + aw) = a0;
    *(uint4*)(smem + aw + 8192) = a1;
    __syncthreads();
#pragma unroll 1
    for (int ks = 0; ks < 16; ++ks) {
        const int cur = (ks & 1) * 16384;
        const int nxt = ks < 15 ? ks + 1 : 15;
        const char* An = Ab + nxt * 128;
        const char* Bn = Bb + nxt * (2 * NT * 1024);
        a0 = *(const uint4*)(An + avo); a1 = *(const uint4*)(An + (avo + 131072u));
#pragma unroll
        for (int ss = 0; ss < 2; ++ss) {
#pragma unroll
            for (int mh = 0; mh < 2; ++mh) {
                bf16x8 af[4];
#pragma unroll
                for (int mt = 0; mt < 4; ++mt) af[mt] = *(const bf16x8*)(smem + cur + (mh * 4 + mt) * 2048 + foff[ss]);
#pragma unroll
                for (int mt = 0; mt < 4; ++mt)
#pragma unroll
                    for (int nt = 0; nt < NT; ++nt) acc[mh * 4 + mt][nt] = mfma16(af[mt], b[ss][nt], acc[mh * 4 + mt][nt]);
            }
#pragma unroll
            for (int nt = 0; nt < NT; ++nt) b[ss][nt] = *(const bf16x8*)(Bn + (bvo + (unsigned)((ss * NT + nt) * 1024)));
        }
        *(uint4*)(smem + (cur ^ 16384) + aw) = a0;
        *(uint4*)(smem + (cur ^ 16384) + aw + 8192) = a1;
        __syncthreads();
    }
}

#define G_VS   0
#define G_VLT  69632
#define G_WS   102400
#define G_Y    0
DEVFN void item_gmlp(const P& p, char* smem, int chunk, int g) {
    int tid_ = threadIdx.x; asm volatile("" : "+v"(tid_)); const int tid = tid_ & 511, lane = tid & 63, w = __builtin_amdgcn_readfirstlane(tid >> 6), fr = lane & 15, fq = lane >> 4;
    float* stats = (float*)(smem + SM_SMALL);
    float* bsv = (float*)(smem + SM_SMALL + 1024);
    if (tid < 128) bsv[tid] = p.gbs[g * 128 + tid];
    f32x4 acc[8][3];
    const u16* A = (const u16*)(p.ws + OFF_H) + (size_t)chunk * 128 * 1024;
    const bf16x8* Bf = (const bf16x8*)(p.ws + OFF_WINF) + ((size_t)g * 768 + w * 96) * 64;
    gemm_core<3>(A, Bf, smem, acc);
    const int d = w * 16 + fr;
    {
        float* VS = (float*)(smem + G_VS);
#pragma unroll
        for (int mt = 0; mt < 8; ++mt)
#pragma unroll
            for (int r = 0; r < 4; ++r) VS[(mt * 16 + fq * 4 + r) * 132 + d] = acc[mt][1][r];
        const uint4* wsg = (const uint4*)((const u16*)(p.ws + OFF_WS) + g * 16384);
#pragma unroll
        for (int i = 0; i < 4; ++i) {
            const int row = (tid >> 4) + 32 * i, ch = tid & 15;
            *(uint4*)(smem + G_WS + swz(row, ch)) = wsg[row * 16 + ch];
        }
    }
    __syncthreads();
    {
        const float* VS = (const float*)(smem + G_VS);
        const int row = tid >> 2, q = tid & 3;
        float v[32];
#pragma unroll
        for (int i = 0; i < 8; ++i) {
            const float4 t4 = *(const float4*)(VS + row * 132 + q * 32 + i * 4);
            v[i * 4 + 0] = t4.x; v[i * 4 + 1] = t4.y; v[i * 4 + 2] = t4.z; v[i * 4 + 3] = t4.w;
        }
        float s = 0.f;
#pragma unroll
        for (int i = 0; i < 32; ++i) s += v[i];
        s += __shfl_xor(s, 1); s += __shfl_xor(s, 2);
        const float mean = s * (1.0f / 128.0f);
        float q2 = 0.f;
#pragma unroll
        for (int i = 0; i < 32; ++i) { const float dv = v[i] - mean; q2 += dv * dv; }
        q2 += __shfl_xor(q2, 1); q2 += __shfl_xor(q2, 2);
        if (q == 0) { stats[row * 2] = mean; stats[row * 2 + 1] = rsqrtf(q2 * (1.0f / 128.0f) + 1e-6f); }
    }
    __syncthreads();
    {
        const float lg = p.ln_g[g * 128 + d];
#pragma unroll
        for (int mt = 0; mt < 8; ++mt) {
            const int s0 = mt * 16 + fq * 4;
            float o[4];
#pragma unroll
            for (int r = 0; r < 4; ++r) {
                const float2 st = *(const float2*)(stats + (s0 + r) * 2);
                o[r] = (acc[mt][1][r] - st.x) * st.y * lg;
            }
            *(uint2*)(smem + G_VLT + swz(d, s0 >> 3) + (s0 & 7) * 2) = pack4(o[0], o[1], o[2], o[3]);
        }
    }
    __syncthreads();
    {
        bf16x8 bv[4];
#pragma unroll
        for (int ks = 0; ks < 4; ++ks) bv[ks] = frag(smem + G_VLT, w, ks, fr, fq);
#pragma unroll
        for (int mt = 0; mt < 8; ++mt) {
            f32x4 m = (f32x4){0.f, 0.f, 0.f, 0.f};
#pragma unroll
            for (int ks = 0; ks < 4; ++ks)
                if (ks * 32 <= mt * 16 + 15) m = mfma16(frag(smem + G_WS, mt, ks, fr, fq), bv[ks], m);
#pragma unroll
            for (int r = 0; r < 4; ++r) {
                const int t = mt * 16 + fq * 4 + r;
                const float o = acc[mt][0][r] * (m[r] + bsv[t]) * silu(acc[mt][2][r]);
                *(u16*)(smem + G_Y + t * 272 + d * 2) = f2bf(o);
            }
        }
    }
    __syncthreads();
    {
        u16* Y = (u16*)(p.ws + OFF_Y) + (size_t)chunk * 128 * 1024 + g * 128;
#pragma unroll
        for (int i = 0; i < 4; ++i) {
            const int row = (tid >> 4) + 32 * i, ch = tid & 15;
            *(uint4*)(Y + (size_t)row * 1024 + ch * 8) = *(const uint4*)(smem + G_Y + row * 272 + ch * 16);
        }
    }
    __syncthreads();
}

#define R_Q   0
#define R_K   32768
#define R_KT  65536
#define R_VT  98304
DEVFN void item_ret(const P& p, char* smem, int chunk, int hh) {
    int tid_ = threadIdx.x; asm volatile("" : "+v"(tid_)); const int tid = tid_ & 511, lane = tid & 63, w = __builtin_amdgcn_readfirstlane(tid >> 6), fr = lane & 15, fq = lane >> 4;
    float* posf = (float*)(smem + SM_SMALL);
    float* kdec = posf + 128;
    float* qdec = posf + 256;
    const float lg = __logf(1.0f - exp2f(-5.0f - (float)hh));
    if (tid < 128) {
        posf[tid] = (float)p.pos[chunk * 128 + tid];
        kdec[tid] = expf((float)(127 - tid) * lg);
        qdec[tid] = expf((float)(tid + 1) * lg);
    }
    f32x4 acc[8][4];
    const u16* A = (const u16*)(p.ws + OFF_H) + (size_t)chunk * 128 * 1024;
    const bf16x8* Bf = (const bf16x8*)(p.ws + OFF_WINF) + ((size_t)3072 + hh * 1024 + w * 128) * 64;
    gemm_core<4>(A, Bf, smem, acc);
    const size_t base = (size_t)(chunk * 4 + hh) * 16384;
    if (w < 4) {
        const int d = w * 16 + fr;
        const float invf = 1.0f / powf(10000.0f, (float)d * (1.0f / 64.0f));
        const float scale = 0.08838834764831845f;
#pragma unroll
        for (int mt = 0; mt < 8; ++mt) {
            float kt1[4], kt2[4];
#pragma unroll
            for (int r = 0; r < 4; ++r) {
                const int t = mt * 16 + fq * 4 + r;
                const float ang = posf[t] * invf;
                float sn, cs;
                sincosf(ang, &sn, &cs);
                const float q1 = acc[mt][0][r], q2 = acc[mt][1][r], k1 = acc[mt][2][r], k2 = acc[mt][3][r];
                const float q1r = q1 * cs - q2 * sn, q2r = q2 * cs + q1 * sn;
                const float k1r = (k1 * cs - k2 * sn) * scale, k2r = (k2 * cs + k1 * sn) * scale;
                *(u16*)(smem + R_Q + swz(t, d >> 3) + (d & 7) * 2) = f2bf(q1r);
                *(u16*)(smem + R_Q + swz(t, (d + 64) >> 3) + (d & 7) * 2) = f2bf(q2r);
                *(u16*)(smem + R_K + swz(t, d >> 3) + (d & 7) * 2) = f2bf(k1r);
                *(u16*)(smem + R_K + swz(t, (d + 64) >> 3) + (d & 7) * 2) = f2bf(k2r);
                kt1[r] = k1r * kdec[t]; kt2[r] = k2r * kdec[t];
            }
            const int t0 = mt * 16 + fq * 4;
            *(uint2*)(smem + R_KT + swz(d, t0 >> 3) + (t0 & 7) * 2) = pack4(kt1[0], kt1[1], kt1[2], kt1[3]);
            *(uint2*)(smem + R_KT + swz(d + 64, t0 >> 3) + (t0 & 7) * 2) = pack4(kt2[0], kt2[1], kt2[2], kt2[3]);
        }
    } else if (w < 6) {
#pragma unroll
        for (int mt = 0; mt < 8; ++mt)
#pragma unroll
            for (int nt = 0; nt < 4; ++nt) {
                const int e = (w - 4) * 64 + nt * 16 + fr, t0 = mt * 16 + fq * 4;
                *(uint2*)(smem + R_VT + swz(e, t0 >> 3) + (t0 & 7) * 2) = pack4(acc[mt][nt][0], acc[mt][nt][1], acc[mt][nt][2], acc[mt][nt][3]);
            }
    } else {
        char* sgb = (char*)((u16*)(p.ws + OFF_SG) + base + (w - 6) * 64);
        const unsigned lo = (unsigned)(fq * 1024 + fr * 2);
#pragma unroll
        for (int mt = 0; mt < 8; ++mt) {
            char* sgm = sgb + mt * 4096;
#pragma unroll
            for (int nt = 0; nt < 4; ++nt)
#pragma unroll
                for (int r = 0; r < 4; ++r) *(u16*)(sgm + (lo + (unsigned)(r * 256 + nt * 32))) = f2bf(silu(acc[mt][nt][r]));
        }
    }
    __syncthreads();
    {
        u16* qd = (u16*)(p.ws + OFF_QD) + base;
#pragma unroll
        for (int i = 0; i < 4; ++i) {
            const int row = (tid >> 4) + 32 * i, ch = tid & 15;
            const uint4 v = *(const uint4*)(smem + R_Q + swz(row, ch));
            const float f = qdec[row];
            uint4 o;
            o.x = pack2(bf2f((u16)(v.x & 0xffff)) * f, bf2f((u16)(v.x >> 16)) * f);
            o.y = pack2(bf2f((u16)(v.y & 0xffff)) * f, bf2f((u16)(v.y >> 16)) * f);
            o.z = pack2(bf2f((u16)(v.z & 0xffff)) * f, bf2f((u16)(v.z >> 16)) * f);
            o.w = pack2(bf2f((u16)(v.w & 0xffff)) * f, bf2f((u16)(v.w >> 16)) * f);
            *(uint4*)(qd + row * 128 + ch * 8) = o;
        }
        f32x4 kv[8];
#pragma unroll
        for (int nt = 0; nt < 8; ++nt) kv[nt] = (f32x4){0.f, 0.f, 0.f, 0.f};
#pragma unroll
        for (int ks = 0; ks < 4; ++ks) {
            const bf16x8 af = frag(smem + R_VT, w, ks, fr, fq);
#pragma unroll
            for (int nt = 0; nt < 8; ++nt) kv[nt] = mfma16(af, frag(smem + R_KT, nt, ks, fr, fq), kv[nt]);
        }
        char* kvb = (char*)((float*)(p.ws + OFF_KV) + base + w * 2048);
        const unsigned lo = (unsigned)(fq * 2048 + fr * 4);
#pragma unroll
        for (int nt = 0; nt < 8; ++nt)
#pragma unroll
            for (int r = 0; r < 4; ++r) *(float*)(kvb + (lo + (unsigned)(r * 512 + nt * 64))) = kv[nt][r];
    }
    __syncthreads();
    {
        f32x4 sa[8];
#pragma unroll
        for (int nt = 0; nt < 8; ++nt) sa[nt] = (f32x4){0.f, 0.f, 0.f, 0.f};
        bf16x8 ka[4];
#pragma unroll
        for (int ks = 0; ks < 4; ++ks) ka[ks] = frag(smem + R_K, w, ks, fr, fq);
#pragma unroll
        for (int nt = 0; nt < 8; ++nt)
            if (nt >= w) {
#pragma unroll
                for (int ks = 0; ks < 4; ++ks) sa[nt] = mfma16(ka[ks], frag(smem + R_Q, nt, ks, fr, fq), sa[nt]);
            }
#pragma unroll
        for (int nt = 0; nt < 8; ++nt) {
            const int t = nt * 16 + fr, s0 = w * 16 + fq * 4;
            float o[4];
#pragma unroll
            for (int r = 0; r < 4; ++r) {
                const int s = s0 + r;
                o[r] = (t >= s) ? sa[nt][r] * __expf((float)(t - s) * lg) : 0.f;
            }
            *(uint2*)(smem + R_KT + swz(t, s0 >> 3) + (s0 & 7) * 2) = pack4(o[0], o[1], o[2], o[3]);
        }
    }
    __syncthreads();
    {
        f32x4 ia[8];
#pragma unroll
        for (int nt = 0; nt < 8; ++nt) ia[nt] = (f32x4){0.f, 0.f, 0.f, 0.f};
#pragma unroll
        for (int ks = 0; ks < 4; ++ks)
            if (ks * 32 <= w * 16 + 15) {
                const bf16x8 af = frag(smem + R_KT, w, ks, fr, fq);
#pragma unroll
                for (int nt = 0; nt < 8; ++nt) ia[nt] = mfma16(af, frag(smem + R_VT, nt, ks, fr, fq), ia[nt]);
            }
        char* igb = (char*)((float*)(p.ws + OFF_INTRA) + base + w * 2048);
        const unsigned lo = (unsigned)(fq * 2048 + fr * 4);
#pragma unroll
        for (int nt = 0; nt < 8; ++nt)
#pragma unroll
            for (int r = 0; r < 4; ++r) *(float*)(igb + (lo + (unsigned)(r * 512 + nt * 64))) = ia[nt][r];
    }
    __syncthreads();
}

DEVFN void phase2(const P& p, char* smem, int bid, int nb) {
    for (int it = bid; it < 2048; it += nb) {
        const int j = it >> 8, chunk = it & 255;
        if (j < 4) item_gmlp(p, smem, chunk, j);
        else item_ret(p, smem, chunk, j - 4);
    }
}

DEVFN void phase3(const P& p, int bid, int nb) {
    const float* KV = (const float*)(p.ws + OFF_KV);
    u16* ST = (u16*)(p.ws + OFF_ST);
    for (int i = bid * NTHREADS + threadIdx.x; i < 262144; i += nb * NTHREADS) {
        const int bh = i >> 12, b = bh >> 2, h = bh & 3, off = (i & 4095) * 4;
        const float lg = __logf(1.0f - exp2f(-5.0f - (float)h));
        const float cd = expf(128.0f * lg);
        float4 kv[15];
#pragma unroll
        for (int n = 0; n < 15; ++n) kv[n] = *(const float4*)(KV + (size_t)((b * 16 + n) * 4 + h) * 16384 + off);
        float4 st = make_float4(0.f, 0.f, 0.f, 0.f);
#pragma unroll
        for (int n = 0; n < 16; ++n) {
            *(uint2*)(ST + (size_t)((b * 16 + n) * 4 + h) * 16384 + off) = pack4(st.x, st.y, st.z, st.w);
            if (n < 15) { st.x = st.x * cd + kv[n].x; st.y = st.y * cd + kv[n].y; st.z = st.z * cd + kv[n].z; st.w = st.w * cd + kv[n].w; }
        }
    }
}

DEVFN void phase45(const P& p, char* smem, int bid, int nb) {
    for (int chunk = bid; chunk < 256; chunk += nb) {
        int tid_ = threadIdx.x; asm volatile("" : "+v"(tid_));
        const int tid = tid_ & 511, lane = tid & 63, w = __builtin_amdgcn_readfirstlane(tid >> 6), fr = lane & 15, fq = lane >> 4;
        const int b = chunk >> 4;
        u16* Yg = (u16*)(p.ws + OFF_Y) + (size_t)chunk * 128 * 1024;
        char* ys = smem + 32768 + w * 4352;
#pragma unroll 1
        for (int hh = 0; hh < 4; ++hh) {
            const size_t base = (size_t)(chunk * 4 + hh) * 16384 + w * 2048;
            const char* qd = (const char*)((const u16*)(p.ws + OFF_QD) + base);
            const char* stt = (const char*)((const u16*)(p.ws + OFF_ST) + (size_t)(chunk * 4 + hh) * 16384);
            const char* ig = (const char*)((const float*)(p.ws + OFF_INTRA) + base);
            const char* sg = (const char*)((const u16*)(p.ws + OFF_SG) + base);
            const unsigned fo = (unsigned)(fr * 256 + fq * 16);
            f32x4 o[8];
#pragma unroll
            for (int nt = 0; nt < 8; ++nt) o[nt] = (f32x4){0.f, 0.f, 0.f, 0.f};
            bf16x8 qa[4];
#pragma unroll
            for (int ks = 0; ks < 4; ++ks) qa[ks] = *(const bf16x8*)(qd + (fo + (unsigned)(ks * 64)));
#pragma unroll
            for (int nt = 0; nt < 8; ++nt)
#pragma unroll
                for (int ks = 0; ks < 4; ++ks)
                    o[nt] = mfma16(qa[ks], *(const bf16x8*)(stt + (fo + (unsigned)(nt * 4096 + ks * 64))), o[nt]);
            const unsigned io = (unsigned)(fq * 2048 + fr * 4);
#pragma unroll
            for (int nt = 0; nt < 8; ++nt)
#pragma unroll
                for (int r = 0; r < 4; ++r) o[nt][r] += *(const float*)(ig + (io + (unsigned)(r * 512 + nt * 64)));
            asm volatile("s_waitcnt lgkmcnt(0)" ::: "memory");
            const unsigned so = (unsigned)(fq * 1024 + fr * 2);
#pragma unroll
            for (int r = 0; r < 4; ++r) {
                float s = 0.f;
#pragma unroll
                for (int nt = 0; nt < 8; ++nt) s += o[nt][r];
                s += __shfl_xor(s, 1); s += __shfl_xor(s, 2); s += __shfl_xor(s, 4); s += __shfl_xor(s, 8);
                const float mean = s * (1.0f / 128.0f);
                float q2 = 0.f;
#pragma unroll
                for (int nt = 0; nt < 8; ++nt) { const float dv = o[nt][r] - mean; q2 += dv * dv; }
                q2 += __shfl_xor(q2, 1); q2 += __shfl_xor(q2, 2); q2 += __shfl_xor(q2, 4); q2 += __shfl_xor(q2, 8);
                const float rstd = rsqrtf(q2 * (1.0f / 128.0f) + 1e-6f);
                const int tl = fq * 4 + r;
#pragma unroll
                for (int nt = 0; nt < 8; ++nt) {
                    const int e = nt * 16 + fr;
                    const float gv = bf2f(*(const u16*)(sg + (so + (unsigned)(r * 256 + nt * 32))));
                    const float yv = (o[nt][r] - mean) * rstd * p.gn_g[hh * 128 + e] * gv;
                    *(u16*)(ys + tl * 272 + e * 2) = f2bf(yv);
                }
            }
            asm volatile("s_waitcnt lgkmcnt(0)" ::: "memory");
            char* yo = (char*)(Yg + (size_t)(w * 16) * 1024 + 512 + hh * 128);
#pragma unroll
            for (int i = 0; i < 4; ++i) {
                const int row = (lane >> 4) + 4 * i, ch = lane & 15;
                *(uint4*)(yo + (unsigned)(row * 2048 + ch * 16)) = *(const uint4*)(ys + row * 272 + ch * 16);
            }
            asm volatile("s_waitcnt lgkmcnt(0)" ::: "memory");
        }
        __threadfence_block();
        __syncthreads();
        float* part = (float*)(smem + SM_SMALL);
        float* rsv = (float*)(smem + 65536);
        f32x4 acc[8][4];
        char* outb = (char*)(p.out + (size_t)chunk * 128 * 1024 + w * 64);
        const char* xb = (const char*)(p.x + (size_t)chunk * 128 * 1024 + w * 64);
        const unsigned oo = (unsigned)(fq * 16384 + fr * 4);
#define ROWSQ(HF) \
        _Pragma("unroll") for (int mt = 0; mt < 8; ++mt) \
        _Pragma("unroll") for (int r = 0; r < 4; ++r) { \
            float s = 0.f; \
            _Pragma("unroll") for (int nt = 0; nt < 4; ++nt) s += acc[mt][nt][r] * acc[mt][nt][r]; \
            s += __shfl_xor(s, 1); s += __shfl_xor(s, 2); s += __shfl_xor(s, 4); s += __shfl_xor(s, 8); \
            if (fr == 0) part[((HF) * 8 + w) * 128 + mt * 16 + fq * 4 + r] = s; \
        }
        {
            const bf16x8* Bf = (const bf16x8*)(p.ws + OFF_WOUTF) + ((size_t)(0 * 8 + w) * 128) * 64;
            gemm_core<4>(Yg, Bf, smem, acc);
            ROWSQ(0)
#pragma unroll
            for (int mt = 0; mt < 8; ++mt)
#pragma unroll
                for (int r = 0; r < 4; ++r) {
                    char* ob = outb + (mt * 16 + r) * 4096;
#pragma unroll
                    for (int nt = 0; nt < 4; ++nt) *(float*)(ob + (oo + (unsigned)(nt * 64))) = acc[mt][nt][r];
                }
        }
        {
            const bf16x8* Bf = (const bf16x8*)(p.ws + OFF_WOUTF) + ((size_t)(1 * 8 + w) * 128) * 64;
            gemm_core<4>(Yg, Bf, smem, acc);
            ROWSQ(1)
        }
        __syncthreads();
        if (tid < 128) {
            float s = 0.f;
#pragma unroll
            for (int k = 0; k < 16; ++k) s += part[k * 128 + tid];
            rsv[tid] = rsqrtf(s * (1.0f / 1024.0f) + 1e-6f);
        }
        __syncthreads();
        const float* gate = (const float*)(p.ws + OFF_MOD) + b * 3072 + 2048;
        {
            float gg[4];
#pragma unroll
            for (int nt = 0; nt < 4; ++nt) { const int col = 512 + w * 64 + nt * 16 + fr; gg[nt] = gate[col] * p.g_post[col]; }
#pragma unroll
            for (int mt = 0; mt < 8; ++mt)
#pragma unroll
                for (int r = 0; r < 4; ++r) {
                    const float rs = rsv[mt * 16 + fq * 4 + r];
                    char* ob = outb + (mt * 16 + r) * 4096 + 2048;
                    const char* xr = xb + (mt * 16 + r) * 4096 + 2048;
#pragma unroll
                    for (int nt = 0; nt < 4; ++nt)
                        *(float*)(ob + (oo + (unsigned)(nt * 64))) = *(const float*)(xr + (oo + (unsigned)(nt * 64))) + gg[nt] * acc[mt][nt][r] * rs;
                }
        }
        {
            const int c4 = (tid & 127) * 4;
            const float4 gt = *(const float4*)(gate + c4);
            const float4 gp = *(const float4*)(p.g_post + c4);
            const float4 gq = make_float4(gt.x * gp.x, gt.y * gp.y, gt.z * gp.z, gt.w * gp.w);
            char* ob = (char*)(p.out + (size_t)chunk * 128 * 1024);
            const char* xr = (const char*)(p.x + (size_t)chunk * 128 * 1024);
            const unsigned vo = (unsigned)((tid >> 7) * 4096 + c4 * 4);
#pragma unroll 4
            for (int i = 0; i < 32; ++i) {
                const float4 z = *(const float4*)(ob + (vo + (unsigned)(i * 16384)));
                const float4 xv = *(const float4*)(xr + (vo + (unsigned)(i * 16384)));
                const float rs = rsv[i * 4 + (tid >> 7)];
                float4 o;
                o.x = xv.x + gq.x * z.x * rs; o.y = xv.y + gq.y * z.y * rs;
                o.z = xv.z + gq.z * z.z * rs; o.w = xv.w + gq.w * z.w * rs;
                *(float4*)(ob + (vo + (unsigned)(i * 16384))) = o;
            }
        }
        __syncthreads();
    }
}

#ifndef N_LAUNCHES
#define N_LAUNCHES 1
#endif

#if N_LAUNCHES == 1
__global__ void __launch_bounds__(NTHREADS) fwd(P p) {
    __shared__ __attribute__((aligned(16))) char smem[SM_TOTAL];
    const int bid = blockIdx.x, nb = gridDim.x;
    if (threadIdx.x == 0) *(uint4*)(smem + SM_BARW) = make_uint4(0u, 0u, 0u, 0u);
    __syncthreads();
    XcdBarrier xb = xcd_barrier_post((unsigned*)(p.ws + OFF_BAR), (volatile LAS unsigned*)(smem + SM_BARW));
    phase0(p, smem, bid, nb);
    xcd_barrier(xb);
    phase1(p, bid, nb);
    xcd_barrier(xb);
    phase2(p, smem, bid, nb);
    xcd_barrier(xb);
    phase3(p, bid, nb);
    xcd_barrier(xb);
    phase45(p, smem, bid, nb);
}
#else
__global__ void __launch_bounds__(NTHREADS) k_phase0(P p) { __shared__ __attribute__((aligned(16))) char smem[SM_TOTAL]; phase0(p, smem, blockIdx.x, gridDim.x); }
__global__ void __launch_bounds__(NTHREADS) k_phase1(P p) { phase1(p, blockIdx.x, gridDim.x); }
__global__ void __launch_bounds__(NTHREADS) k_phase2(P p) { __shared__ __attribute__((aligned(16))) char smem[SM_TOTAL]; phase2(p, smem, blockIdx.x, gridDim.x); }
__global__ void __launch_bounds__(NTHREADS) k_phase3(P p) { phase3(p, blockIdx.x, gridDim.x); }
__global__ void __launch_bounds__(NTHREADS) k_phase45(P p) { __shared__ __attribute__((aligned(16))) char smem[SM_TOTAL]; phase45(p, smem, blockIdx.x, gridDim.x); }
#endif

extern "C" void kernel_launch(void* const* d_in, const int* in_sizes, int n_in, void* d_out, int out_size, void* d_ws, size_t ws_size,
                              hipStream_t stream) {
    P p{};
    p.x = (const float*)d_in[0]; p.c = (const float*)d_in[1]; p.pos = (const int*)d_in[2]; p.w_ada = (const float*)d_in[3];
    p.b_ada = (const float*)d_in[4]; p.g_pre = (const float*)d_in[5]; p.w_in = (const float*)d_in[6]; p.ln_g = (const float*)d_in[7];
    p.gws = (const float*)d_in[8]; p.gbs = (const float*)d_in[9]; p.gn_g = (const float*)d_in[10]; p.w_out = (const float*)d_in[11];
    p.g_post = (const float*)d_in[12]; p.out = (float*)d_out; p.ws = (char*)d_ws;
    p.ph_lo = 0; p.ph_hi = 5;
    const int grid = 256;
#if N_LAUNCHES == 1
    (void)hipMemsetAsync((char*)d_ws + OFF_BAR, 0, XCD_BAR_WORDS * 4, stream);
    void* args[] = {&p};
    hipError_t e = hipLaunchCooperativeKernel((const void*)fwd, dim3(grid), dim3(NTHREADS), args, 0, stream);
    if (e != hipSuccess) fprintf(stderr, "cooperative launch failed: %s\n", hipGetErrorString(e));
#else
    hipLaunchKernelGGL(k_phase0, dim3(grid), dim3(NTHREADS), 0, stream, p);
    hipLaunchKernelGGL(k_phase1, dim3(grid), dim3(NTHREADS), 0, stream, p);
    hipLaunchKernelGGL(k_phase2, dim3(grid), dim3(NTHREADS), 0, stream, p);
    hipLaunchKernelGGL(k_phase3, dim3(grid), dim3(NTHREADS), 0, stream, p);
    hipLaunchKernelGGL(k_phase45, dim3(grid), dim3(NTHREADS), 0, stream, p);
#endif
}
```

```cpp
#include <hip/hip_runtime.h>
#include <stdint.h>
#include <stdio.h>

typedef __attribute__((ext_vector_type(8))) short bf16x8;
typedef __attribute__((ext_vector_type(4))) float f32x4;
typedef unsigned short u16;
#define DEVFN __device__ __forceinline__
#define NTHREADS 512
#define LAS __attribute__((address_space(3)))

#define OFF_BAR    0ull
#define OFF_MOD    16384ull
#define OFF_WINF   262144ull
#define OFF_WOUTF  7602176ull
#define OFF_WS     9699328ull
#define OFF_H      16777216ull
#define OFF_Y      83886080ull
#define OFF_QD     150994944ull
#define OFF_SG     184549376ull
#define OFF_INTRA  218103808ull
#define OFF_KV     285212672ull
#define OFF_ST     352321536ull
#define OFF_TAB    385875968ull
#define OFF_Z      OFF_H

#define SM_SMALL   139264
#define SM_BARW    147456
#define SM_TOTAL   (147456 + 16)

struct P {
    const float* x; const float* c; const int* pos; const float* w_ada; const float* b_ada; const float* g_pre;
    const float* w_in; const float* ln_g; const float* gws; const float* gbs; const float* gn_g; const float* w_out;
    const float* g_post; float* out; char* ws;
    int ph_lo, ph_hi;
};

DEVFN u16 f2bf(float f) {
    uint32_t u = __float_as_uint(f);
    u += 0x7fffu + ((u >> 16) & 1u);
    return (u16)(u >> 16);
}
DEVFN float bf2f(u16 h) { return __uint_as_float(((uint32_t)h) << 16); }
DEVFN uint32_t pack2(float a, float b) { return (uint32_t)f2bf(a) | ((uint32_t)f2bf(b) << 16); }
DEVFN uint2 pack4(float a, float b, float c, float d) { uint2 r; r.x = pack2(a, b); r.y = pack2(c, d); return r; }
DEVFN float silu(float x) { return x * __builtin_amdgcn_rcpf(1.0f + __expf(-x)); }
DEVFN float swap1(float v) { return __int_as_float(__builtin_amdgcn_update_dpp(0, __float_as_int(v), 0xB1, 0xF, 0xF, true)); }
DEVFN uint32_t pair_pack(float a, float b, int odd) {
    const float recv = swap1(odd ? a : b);
    return odd ? pack2(recv, b) : pack2(a, recv);
}
DEVFN int swz(int row, int chunk) { return row * 256 + ((chunk ^ (row & 15)) << 4); }
DEVFN bf16x8 frag(const char* base, int tile, int ks, int fr, int fq) {
    return *(const bf16x8*)(base + swz(tile * 16 + fr, ks * 4 + fq));
}
DEVFN f32x4 mfma16(bf16x8 a, bf16x8 b, f32x4 c) { return __builtin_amdgcn_mfma_f32_16x16x32_bf16(a, b, c, 0, 0, 0); }

#define XB_TMO      128
#define XB_XCNT(j)  (256  + 64 * (j))
#define XB_XSUB(j)  (1280 + 64 * (j))
#define XB_XGEN(j)  (2304 + 64 * (j))
#define XB_TOP      3328
#define XB_TOPGEN   3392
#define XCD_BAR_WORDS 3456
#define XB_SPIN_CAP (1u << 22)
DEVFN unsigned xb_ld(unsigned* p) { return __hip_atomic_load(p, __ATOMIC_RELAXED, __HIP_MEMORY_SCOPE_AGENT); }
DEVFN unsigned xb_add(unsigned* p, unsigned v) { return __hip_atomic_fetch_add(p, v, __ATOMIC_RELAXED, __HIP_MEMORY_SCOPE_AGENT); }
DEVFN unsigned xb_xcc_id() { return (unsigned)__builtin_amdgcn_s_getreg((3 << 11) | 20) & 0xFu; }
#define XB_SPIN(cond, bar) do { unsigned _sp = 0; while (cond) { __builtin_amdgcn_s_sleep(1); \
    if ((++_sp & 255u) == 0u) { if (xb_ld(&(bar)[XB_TMO])) break; if (_sp > XB_SPIN_CAP) { atomicAdd(&(bar)[XB_TMO], 1u); break; } } } } while (0)
struct XcdBarrier { unsigned* bar; unsigned x; volatile LAS unsigned* st; };
DEVFN XcdBarrier xcd_barrier_post(unsigned* bar, volatile LAS unsigned* st) {
    XcdBarrier b; b.bar = bar; b.x = xb_xcc_id(); b.st = st;
    if (threadIdx.x == 0) (void)xb_add(&bar[XB_XCNT(b.x)], 1u);
    return b;
}
DEVFN void xcd_barrier_complete(unsigned* bar, unsigned x, unsigned& nloc, unsigned& nx) {
    const unsigned G = gridDim.x * gridDim.y * gridDim.z;
    unsigned sum, cnt, mine, sp = 0u;
    for (;;) {
        sum = 0u; cnt = 0u; mine = 0u;
#pragma unroll
        for (unsigned j = 0; j < 16; ++j) { const unsigned c = xb_ld(&bar[XB_XCNT(j)]); sum += c; cnt += (c > 0u) ? 1u : 0u; mine = (j == x) ? c : mine; }
        if (sum == G) break;
        __builtin_amdgcn_s_sleep(1);
        if ((++sp & 255u) == 0u) { if (xb_ld(&bar[XB_TMO])) break; if (sp > XB_SPIN_CAP) { atomicAdd(&bar[XB_TMO], 1u); break; } }
    }
    nloc = mine > 0u ? mine : 1u; nx = cnt > 0u ? cnt : 1u;
}
DEVFN void xcd_barrier(const XcdBarrier& b) {
    asm volatile("s_waitcnt vmcnt(0)" ::: "memory");
    __syncthreads();
    if (threadIdx.x == 0) {
        unsigned* bar = b.bar;
        __builtin_amdgcn_s_waitcnt(0);
        unsigned nloc = b.st[0], nx = b.st[1];
        if (nloc == 0u) { xcd_barrier_complete(bar, b.x, nloc, nx); b.st[0] = nloc; b.st[1] = nx; }
        const unsigned old = xb_add(&bar[XB_XSUB(b.x)], 1u);
        const unsigned gen = old / nloc;
        if (old + 1u == (gen + 1u) * nloc) {
            __builtin_amdgcn_fence(__ATOMIC_RELEASE, "agent");
            asm volatile("s_waitcnt vmcnt(0)" ::: "memory");
            const unsigned og = xb_add(&bar[XB_TOP], 1u);
            const unsigned tg = og / nx;
            if (og + 1u == (tg + 1u) * nx) xb_add(&bar[XB_TOPGEN], 1u);
            else XB_SPIN(xb_ld(&bar[XB_TOPGEN]) == tg, bar);
            __builtin_amdgcn_fence(__ATOMIC_ACQUIRE, "agent");
            xb_add(&bar[XB_XGEN(b.x)], 1u);
            asm volatile("s_waitcnt vmcnt(0)" ::: "memory");
        } else {
            XB_SPIN(xb_ld(&bar[XB_XGEN(b.x)]) == gen, bar);
            __builtin_amdgcn_fence(__ATOMIC_ACQUIRE, "agent");
            asm volatile("s_waitcnt vmcnt(0)" ::: "memory");
        }
    }
    __syncthreads();
}

DEVFN int proj_feature(int j, int w, int nt, int c) {
    if (j < 4) return nt * 512 + j * 128 + w * 16 + c;
    const int hh = j - 4;
    if (w < 4) return (nt < 2 ? 1536 : 2048) + hh * 128 + (nt & 1) * 64 + w * 16 + c;
    if (w < 6) return 2560 + hh * 128 + (w - 4) * 64 + nt * 16 + c;
    return 3072 + hh * 128 + (w - 6) * 64 + nt * 16 + c;
}

DEVFN void phase0(const P& p, char* smem, int bid, int nb) {
    const int tid = threadIdx.x, lane = tid & 63, w = __builtin_amdgcn_readfirstlane(tid >> 6);
    const int N_MOD = 96, N_WIN = 896, N_WOUT = 256, N_WS = 16;
    const int NITEMS = N_MOD + N_WIN + N_WOUT + N_WS;
    for (int it = bid; it < NITEMS; it += nb) {
        if (it < N_MOD) {
            float* sc = (float*)smem;
            float* red = (float*)(smem + 65536);
            __syncthreads();
            for (int i = tid; i < 16384; i += NTHREADS) sc[i] = silu(p.c[i]);
            __syncthreads();
            const int col = tid & 31, kg = tid >> 5, e0 = it * 32;
            float acc[16];
#pragma unroll
            for (int b = 0; b < 16; ++b) acc[b] = 0.f;
#pragma unroll 4
            for (int dd = 0; dd < 64; ++dd) {
                const int d = kg * 64 + dd;
                const float wv = p.w_ada[(size_t)d * 3072 + e0 + col];
#pragma unroll
                for (int b = 0; b < 16; ++b) acc[b] += sc[b * 1024 + d] * wv;
            }
#pragma unroll
            for (int b = 0; b < 16; ++b) red[(kg * 16 + b) * 32 + col] = acc[b];
            __syncthreads();
            {
                const int b = tid >> 5;
                float s = p.b_ada[e0 + col];
#pragma unroll
                for (int k = 0; k < 16; ++k) s += red[(k * 16 + b) * 32 + col];
                ((float*)(p.ws + OFF_MOD))[b * 3072 + e0 + col] = s;
            }
        } else if (it < N_MOD + N_WIN) {
            const int F = (it - N_MOD) * 8 + w;
            int j, ww, ks, nt;
            if (F < 3072) { j = F / 768; int rem = F % 768; ww = rem / 96; int r2 = rem % 96; ks = r2 / 3; nt = r2 % 3; }
            else { int f2 = F - 3072; j = 4 + f2 / 1024; int rem = f2 % 1024; ww = rem / 128; int r2 = rem % 128; ks = r2 / 4; nt = r2 % 4; }
            const int f = proj_feature(j, ww, nt, lane & 15);
            const int k0 = ks * 32 + (lane >> 4) * 8;
            float v[8];
#pragma unroll
            for (int q = 0; q < 8; ++q) v[q] = p.w_in[(size_t)(k0 + q) * 3584 + f];
            uint4 o; o.x = pack2(v[0], v[1]); o.y = pack2(v[2], v[3]); o.z = pack2(v[4], v[5]); o.w = pack2(v[6], v[7]);
            ((uint4*)(p.ws + OFF_WINF))[(size_t)F * 64 + lane] = o;
        } else if (it < N_MOD + N_WIN + N_WOUT) {
            const int F = (it - N_MOD - N_WIN) * 8 + w;
            const int nt = F & 3, ks = (F >> 2) & 31, hw = F >> 7;
            const int n = hw * 64 + nt * 16 + (lane & 15);
            const int k0 = ks * 32 + (lane >> 4) * 8;
            float v[8];
#pragma unroll
            for (int q = 0; q < 8; ++q) v[q] = p.w_out[(size_t)(k0 + q) * 1024 + n];
            uint4 o; o.x = pack2(v[0], v[1]); o.y = pack2(v[2], v[3]); o.z = pack2(v[4], v[5]); o.w = pack2(v[6], v[7]);
            ((uint4*)(p.ws + OFF_WOUTF))[(size_t)F * 64 + lane] = o;
        } else {
            const int base = (it - N_MOD - N_WIN - N_WOUT) * 4096 + tid * 8;
            const int t = (base >> 7) & 127, s0 = base & 127;
            float v[8];
#pragma unroll
            for (int q = 0; q < 8; ++q) v[q] = (s0 + q <= t) ? p.gws[base + q] : 0.f;
            uint4 o; o.x = pack2(v[0], v[1]); o.y = pack2(v[2], v[3]); o.z = pack2(v[4], v[5]); o.w = pack2(v[6], v[7]);
            *(uint4*)((u16*)(p.ws + OFF_WS) + base) = o;
        }
    }
}

DEVFN void phase1(const P& p, int bid, int nb) {
    const int tid = threadIdx.x, lane = tid & 63, w = __builtin_amdgcn_readfirstlane(tid >> 6);
    const float* mod = (const float*)(p.ws + OFF_MOD);
    u16* H = (u16*)(p.ws + OFF_H);
    for (int rg = bid * 8 + w; rg < 2048; rg += nb * 8) {
        const int b = rg >> 7;

        float gs[16], sh[16];
#pragma unroll
        for (int i = 0; i < 4; ++i) {
            const int col = (i * 64 + lane) * 4;
            const float4 g = *(const float4*)(p.g_pre + col);
            const float4 s = *(const float4*)(mod + b * 3072 + 1024 + col);
            const float4 t = *(const float4*)(mod + b * 3072 + col);
            gs[i * 4 + 0] = g.x * (1.f + s.x); gs[i * 4 + 1] = g.y * (1.f + s.y); gs[i * 4 + 2] = g.z * (1.f + s.z); gs[i * 4 + 3] = g.w * (1.f + s.w);
            sh[i * 4 + 0] = t.x; sh[i * 4 + 1] = t.y; sh[i * 4 + 2] = t.z; sh[i * 4 + 3] = t.w;
        }
#pragma unroll 4
        for (int r = 0; r < 16; ++r) {
            const size_t row = (size_t)rg * 16 + r;
            const float4* xr = (const float4*)(p.x + row * 1024);
            float4 v[4];
#pragma unroll
            for (int i = 0; i < 4; ++i) v[i] = xr[i * 64 + lane];
            float ss = 0.f;
#pragma unroll
            for (int i = 0; i < 4; ++i) ss += v[i].x * v[i].x + v[i].y * v[i].y + v[i].z * v[i].z + v[i].w * v[i].w;
#pragma unroll
            for (int m = 32; m >= 1; m >>= 1) ss += __shfl_xor(ss, m);
            const float rs = rsqrtf(ss * (1.0f / 1024.0f) + 1e-6f);
#pragma unroll
            for (int i = 0; i < 4; ++i) {
                const uint2 o = pack4(v[i].x * rs * gs[i * 4 + 0] + sh[i * 4 + 0], v[i].y * rs * gs[i * 4 + 1] + sh[i * 4 + 1],
                                      v[i].z * rs * gs[i * 4 + 2] + sh[i * 4 + 2], v[i].w * rs * gs[i * 4 + 3] + sh[i * 4 + 3]);
                *(uint2*)(H + row * 1024 + (i * 64 + lane) * 4) = o;
            }
        }
    }
}

template <int NT>
DEVFN void gemm_step(const char* An, const char* Bn, const unsigned avo, const unsigned bvo, char* smem, const int cur, const int aw,
                     const int foff0, const int foff1, f32x4 (&acc)[8][NT], const bf16x8 (&bc)[2][NT], bf16x8 (&bn)[2][NT]) {
    const uint4 a0 = *(const uint4*)(An + avo), a1 = *(const uint4*)(An + (avo + 131072u));
#pragma unroll
    for (int ss = 0; ss < 2; ++ss)
#pragma unroll
        for (int nt = 0; nt < NT; ++nt) bn[ss][nt] = *(const bf16x8*)(Bn + (bvo + (unsigned)((ss * NT + nt) * 1024)));
    __builtin_amdgcn_sched_barrier(0);
    {
        bf16x8 x0 = *(const bf16x8*)(smem + cur + foff0), x1 = *(const bf16x8*)(smem + cur + 2048 + foff0);
#pragma unroll
        for (int g = 0; g < 8; ++g) {
            const int ss = g >> 2, m0 = (g & 3) * 2;
            bf16x8 y0 = x0, y1 = x1;
            if (g < 7) {
                const int gn = g + 1, fo = (gn >> 2) ? foff1 : foff0, mn = (gn & 3) * 2;
                y0 = *(const bf16x8*)(smem + cur + mn * 2048 + fo);
                y1 = *(const bf16x8*)(smem + cur + (mn + 1) * 2048 + fo);
            }
            __builtin_amdgcn_sched_barrier(0);
#pragma unroll
            for (int nt = 0; nt < NT; ++nt) {
                acc[m0][nt] = mfma16(x0, bc[ss][nt], acc[m0][nt]);
                acc[m0 + 1][nt] = mfma16(x1, bc[ss][nt], acc[m0 + 1][nt]);
            }
            x0 = y0; x1 = y1;
        }
    }
    __builtin_amdgcn_sched_barrier(0);
    *(uint4*)(smem + (cur ^ 16384) + aw) = a0;
    *(uint4*)(smem + (cur ^ 16384) + aw + 8192) = a1;
    __syncthreads();
}

template <int NT>
DEVFN void gemm_core(const u16* __restrict__ A, const bf16x8* __restrict__ Bf, char* smem, f32x4 (&acc)[8][NT]) {
    int tid_ = threadIdx.x; asm volatile("" : "+v"(tid_));
    const int tid = tid_ & 511, lane = tid & 63;
    const int fr = lane & 15, fq = lane >> 4;
    const int ar = tid >> 3, ac = tid & 7;
    const char* Ab = (const char*)A;
    const char* Bb = (const char*)Bf;
    const unsigned avo = (unsigned)(ar * 2048 + ac * 16);
    const unsigned bvo = (unsigned)(lane * 16);
    const int aw = ar * 128 + ((ac ^ (ar & 7)) << 4);
    const int foff0 = fr * 128 + (((0 + fq) ^ (fr & 7)) << 4);
    const int foff1 = fr * 128 + (((4 + fq) ^ (fr & 7)) << 4);
#pragma unroll
    for (int mt = 0; mt < 8; ++mt)
#pragma unroll
        for (int nt = 0; nt < NT; ++nt) acc[mt][nt] = (f32x4){0.f, 0.f, 0.f, 0.f};
    {
        const uint4 a0 = *(const uint4*)(Ab + avo), a1 = *(const uint4*)(Ab + (avo + 131072u));
        *(uint4*)(smem + aw) = a0;
        *(uint4*)(smem + aw + 8192) = a1;
    }
    bf16x8 b0[2][NT], b1[2][NT];
#pragma unroll
    for (int ss = 0; ss < 2; ++ss)
#pragma unroll
        for (int nt = 0; nt < NT; ++nt) b0[ss][nt] = *(const bf16x8*)(Bb + (bvo + (unsigned)((ss * NT + nt) * 1024)));
    __syncthreads();
#pragma unroll 1
    for (int k2 = 0; k2 < 8; ++k2) {
        const int n1 = 2 * k2 + 1;
        const int n2 = k2 < 7 ? 2 * k2 + 2 : 15;
        gemm_step<NT>(Ab + n1 * 128, Bb + n1 * (2 * NT * 1024), avo, bvo, smem, 0, aw, foff0, foff1, acc, b0, b1);
        gemm_step<NT>(Ab + n2 * 128, Bb + n2 * (2 * NT * 1024), avo, bvo, smem, 16384, aw, foff0, foff1, acc, b1, b0);
    }
}

#define G_VS   0
#define G_VLT  69632
#define G_WS   102400
#define G_Y    0
DEVFN void item_gmlp(const P& p, char* smem, int chunk, int g) {
    int tid_ = threadIdx.x; asm volatile("" : "+v"(tid_)); const int tid = tid_ & 511, lane = tid & 63, w = __builtin_amdgcn_readfirstlane(tid >> 6), fr = lane & 15, fq = lane >> 4;
    float* stats = (float*)(smem + SM_SMALL);
    float* bsv = (float*)(smem + SM_SMALL + 1024);
    if (tid < 128) bsv[tid] = p.gbs[g * 128 + tid];
    f32x4 acc[8][3];
    const u16* A = (const u16*)(p.ws + OFF_H) + (size_t)chunk * 128 * 1024;
    const bf16x8* Bf = (const bf16x8*)(p.ws + OFF_WINF) + ((size_t)g * 768 + w * 96) * 64;
    gemm_core<3>(A, Bf, smem, acc);
    const int d = w * 16 + fr;
    {
        float* VS = (float*)(smem + G_VS);
#pragma unroll
        for (int mt = 0; mt < 8; ++mt)
#pragma unroll
            for (int r = 0; r < 4; ++r) VS[(mt * 16 + fq * 4 + r) * 132 + d] = acc[mt][1][r];
        const uint4* wsg = (const uint4*)((const u16*)(p.ws + OFF_WS) + g * 16384);
#pragma unroll
        for (int i = 0; i < 4; ++i) {
            const int row = (tid >> 4) + 32 * i, ch = tid & 15;
            *(uint4*)(smem + G_WS + swz(row, ch)) = wsg[row * 16 + ch];
        }
    }
    __syncthreads();
    {
        const float* VS = (const float*)(smem + G_VS);
        const int row = tid >> 2, q = tid & 3;
        float v[32];
#pragma unroll
        for (int i = 0; i < 8; ++i) {
            const float4 t4 = *(const float4*)(VS + row * 132 + q * 32 + i * 4);
            v[i * 4 + 0] = t4.x; v[i * 4 + 1] = t4.y; v[i * 4 + 2] = t4.z; v[i * 4 + 3] = t4.w;
        }
        float s = 0.f;
#pragma unroll
        for (int i = 0; i < 32; ++i) s += v[i];
        s += __shfl_xor(s, 1); s += __shfl_xor(s, 2);
        const float mean = s * (1.0f / 128.0f);
        float q2 = 0.f;
#pragma unroll
        for (int i = 0; i < 32; ++i) { const float dv = v[i] - mean; q2 += dv * dv; }
        q2 += __shfl_xor(q2, 1); q2 += __shfl_xor(q2, 2);
        if (q == 0) { stats[row * 2] = mean; stats[row * 2 + 1] = rsqrtf(q2 * (1.0f / 128.0f) + 1e-6f); }
    }
    __syncthreads();
    {
        const float lg = p.ln_g[g * 128 + d];
#pragma unroll
        for (int mt = 0; mt < 8; ++mt) {
            const int s0 = mt * 16 + fq * 4;
            float o[4];
#pragma unroll
            for (int r = 0; r < 4; ++r) {
                const float2 st = *(const float2*)(stats + (s0 + r) * 2);
                o[r] = (acc[mt][1][r] - st.x) * st.y * lg;
            }
            *(uint2*)(smem + G_VLT + swz(d, s0 >> 3) + (s0 & 7) * 2) = pack4(o[0], o[1], o[2], o[3]);
        }
    }
    __syncthreads();
    {
        bf16x8 bv[4];
#pragma unroll
        for (int ks = 0; ks < 4; ++ks) bv[ks] = frag(smem + G_VLT, w, ks, fr, fq);
#pragma unroll
        for (int mt = 0; mt < 8; ++mt) {
            f32x4 m = (f32x4){0.f, 0.f, 0.f, 0.f};
#pragma unroll
            for (int ks = 0; ks < 4; ++ks)
                if (ks * 32 <= mt * 16 + 15) m = mfma16(frag(smem + G_WS, mt, ks, fr, fq), bv[ks], m);
#pragma unroll
            for (int r = 0; r < 4; ++r) {
                const int t = mt * 16 + fq * 4 + r;
                const float o = acc[mt][0][r] * (m[r] + bsv[t]) * silu(acc[mt][2][r]);
                *(u16*)(smem + G_Y + t * 272 + d * 2) = f2bf(o);
            }
        }
    }
    __syncthreads();
    {
        u16* Y = (u16*)(p.ws + OFF_Y) + (size_t)chunk * 128 * 1024 + g * 128;
#pragma unroll
        for (int i = 0; i < 4; ++i) {
            const int row = (tid >> 4) + 32 * i, ch = tid & 15;
            *(uint4*)(Y + (size_t)row * 1024 + ch * 8) = *(const uint4*)(smem + G_Y + row * 272 + ch * 16);
        }
    }
    __syncthreads();
}

#define R_Q   0
#define R_K   32768
#define R_KT  65536
#define R_VT  98304
DEVFN void item_ret(const P& p, char* smem, int chunk, int hh) {
    int tid_ = threadIdx.x; asm volatile("" : "+v"(tid_)); const int tid = tid_ & 511, lane = tid & 63, w = __builtin_amdgcn_readfirstlane(tid >> 6), fr = lane & 15, fq = lane >> 4;
    float* posf = (float*)(smem + SM_SMALL);
    float* kdec = posf + 128;
    float* qdec = posf + 256;
    const float lg = __logf(1.0f - exp2f(-5.0f - (float)hh));
    if (tid < 128) {
        posf[tid] = (float)p.pos[chunk * 128 + tid];
        kdec[tid] = expf((float)(127 - tid) * lg);
        qdec[tid] = expf((float)(tid + 1) * lg);
    }
    f32x4 acc[8][4];
    const u16* A = (const u16*)(p.ws + OFF_H) + (size_t)chunk * 128 * 1024;
    const bf16x8* Bf = (const bf16x8*)(p.ws + OFF_WINF) + ((size_t)3072 + hh * 1024 + w * 128) * 64;
    gemm_core<4>(A, Bf, smem, acc);
    const size_t base = (size_t)(chunk * 4 + hh) * 16384;
    const int odd = fr & 1;
    if (w < 4) {
        const int d = w * 16 + fr, de = d & ~1;
        const float scale = 0.08838834764831845f;
        const float invf = 1.0f / powf(10000.0f, (float)d * (1.0f / 64.0f));
#pragma unroll
        for (int mt = 0; mt < 8; ++mt) {
            float q1r[4], q2r[4], k1r[4], k2r[4];
#pragma unroll
            for (int r = 0; r < 4; ++r) {
                const float rev = (posf[mt * 16 + fq * 4 + r] * invf) * 0.15915494309189535f;
                const float frv = rev - floorf(rev);
                const float cs = __builtin_amdgcn_cosf(frv), sn = __builtin_amdgcn_sinf(frv);
                const float q1 = acc[mt][0][r], q2 = acc[mt][1][r], k1 = acc[mt][2][r], k2 = acc[mt][3][r];
                q1r[r] = q1 * cs - q2 * sn; q2r[r] = q2 * cs + q1 * sn;
                k1r[r] = (k1 * cs - k2 * sn) * scale; k2r[r] = (k2 * cs + k1 * sn) * scale;
            }
            const int t0 = mt * 16 + fq * 4;
            const float4 kd = *(const float4*)(kdec + t0);
            *(uint2*)(smem + R_KT + swz(d, t0 >> 3) + (t0 & 7) * 2) = pack4(k1r[0] * kd.x, k1r[1] * kd.y, k1r[2] * kd.z, k1r[3] * kd.w);
            *(uint2*)(smem + R_KT + swz(d + 64, t0 >> 3) + (t0 & 7) * 2) = pack4(k2r[0] * kd.x, k2r[1] * kd.y, k2r[2] * kd.z, k2r[3] * kd.w);
#pragma unroll
            for (int rp = 0; rp < 2; ++rp) {
                const int tr = t0 + rp * 2 + odd;
                *(uint32_t*)(smem + R_Q + swz(tr, de >> 3) + (de & 7) * 2) = pair_pack(q1r[rp * 2], q1r[rp * 2 + 1], odd);
                *(uint32_t*)(smem + R_Q + swz(tr, (de + 64) >> 3) + (de & 7) * 2) = pair_pack(q2r[rp * 2], q2r[rp * 2 + 1], odd);
                *(uint32_t*)(smem + R_K + swz(tr, de >> 3) + (de & 7) * 2) = pair_pack(k1r[rp * 2], k1r[rp * 2 + 1], odd);
                *(uint32_t*)(smem + R_K + swz(tr, (de + 64) >> 3) + (de & 7) * 2) = pair_pack(k2r[rp * 2], k2r[rp * 2 + 1], odd);
            }
        }
    } else if (w < 6) {
#pragma unroll
        for (int mt = 0; mt < 8; ++mt)
#pragma unroll
            for (int nt = 0; nt < 4; ++nt) {
                const int e = (w - 4) * 64 + nt * 16 + fr, t0 = mt * 16 + fq * 4;
                *(uint2*)(smem + R_VT + swz(e, t0 >> 3) + (t0 & 7) * 2) = pack4(acc[mt][nt][0], acc[mt][nt][1], acc[mt][nt][2], acc[mt][nt][3]);
            }
    } else {
        char* sgb = (char*)((u16*)(p.ws + OFF_SG) + base + (w - 6) * 64);
        const unsigned lo = (unsigned)((fq * 4 + odd) * 256 + (fr & ~1) * 2);
#pragma unroll
        for (int mt = 0; mt < 8; ++mt) {
            char* sgm = sgb + mt * 4096;
#pragma unroll
            for (int nt = 0; nt < 4; ++nt)
#pragma unroll
                for (int rp = 0; rp < 2; ++rp)
                    *(uint32_t*)(sgm + (lo + (unsigned)(rp * 512 + nt * 32))) = pair_pack(silu(acc[mt][nt][rp * 2]), silu(acc[mt][nt][rp * 2 + 1]), odd);
        }
    }
    __syncthreads();
    {
        u16* qd = (u16*)(p.ws + OFF_QD) + base;
#pragma unroll
        for (int i = 0; i < 4; ++i) {
            const int row = (tid >> 4) + 32 * i, ch = tid & 15;
            const uint4 v = *(const uint4*)(smem + R_Q + swz(row, ch));
            const float f = qdec[row];
            uint4 o;
            o.x = pack2(bf2f((u16)(v.x & 0xffff)) * f, bf2f((u16)(v.x >> 16)) * f);
            o.y = pack2(bf2f((u16)(v.y & 0xffff)) * f, bf2f((u16)(v.y >> 16)) * f);
            o.z = pack2(bf2f((u16)(v.z & 0xffff)) * f, bf2f((u16)(v.z >> 16)) * f);
            o.w = pack2(bf2f((u16)(v.w & 0xffff)) * f, bf2f((u16)(v.w >> 16)) * f);
            *(uint4*)(qd + row * 128 + ch * 8) = o;
        }
        f32x4 kv[8];
#pragma unroll
        for (int nt = 0; nt < 8; ++nt) kv[nt] = (f32x4){0.f, 0.f, 0.f, 0.f};
#pragma unroll
        for (int ks = 0; ks < 4; ++ks) {
            const bf16x8 af = frag(smem + R_VT, w, ks, fr, fq);
#pragma unroll
            for (int nt = 0; nt < 8; ++nt) kv[nt] = mfma16(af, frag(smem + R_KT, nt, ks, fr, fq), kv[nt]);
        }
        char* kvb = (char*)((u16*)(p.ws + OFF_KV) + base + w * 2048);
        const unsigned lo = (unsigned)((fq * 4 + odd) * 256 + (fr & ~1) * 2);
#pragma unroll
        for (int nt = 0; nt < 8; ++nt)
#pragma unroll
            for (int rp = 0; rp < 2; ++rp)
                *(uint32_t*)(kvb + (lo + (unsigned)(rp * 512 + nt * 32))) = pair_pack(kv[nt][rp * 2], kv[nt][rp * 2 + 1], odd);
    }
    __syncthreads();
    {
        f32x4 sa[8];
#pragma unroll
        for (int nt = 0; nt < 8; ++nt) sa[nt] = (f32x4){0.f, 0.f, 0.f, 0.f};
        bf16x8 ka[4];
#pragma unroll
        for (int ks = 0; ks < 4; ++ks) ka[ks] = frag(smem + R_K, w, ks, fr, fq);
#pragma unroll
        for (int nt = 0; nt < 8; ++nt)
            if (nt >= w) {
#pragma unroll
                for (int ks = 0; ks < 4; ++ks) sa[nt] = mfma16(ka[ks], frag(smem + R_Q, nt, ks, fr, fq), sa[nt]);
            }
#pragma unroll
        for (int nt = 0; nt < 8; ++nt) {
            const int t = nt * 16 + fr, s0 = w * 16 + fq * 4;
            float o[4];
#pragma unroll
            for (int r = 0; r < 4; ++r) {
                const int s = s0 + r;
                o[r] = (t >= s) ? sa[nt][r] * __expf((float)(t - s) * lg) : 0.f;
            }
            *(uint2*)(smem + R_KT + swz(t, s0 >> 3) + (s0 & 7) * 2) = pack4(o[0], o[1], o[2], o[3]);
        }
    }
    __syncthreads();
    {
        f32x4 ia[8];
#pragma unroll
        for (int nt = 0; nt < 8; ++nt) ia[nt] = (f32x4){0.f, 0.f, 0.f, 0.f};
#pragma unroll
        for (int ks = 0; ks < 4; ++ks)
            if (ks * 32 <= w * 16 + 15) {
                const bf16x8 af = frag(smem + R_KT, w, ks, fr, fq);
#pragma unroll
                for (int nt = 0; nt < 8; ++nt) ia[nt] = mfma16(af, frag(smem + R_VT, nt, ks, fr, fq), ia[nt]);
            }
        char* igb = (char*)((u16*)(p.ws + OFF_INTRA) + base + w * 2048);
        const unsigned lo = (unsigned)((fq * 4 + odd) * 256 + (fr & ~1) * 2);
#pragma unroll
        for (int nt = 0; nt < 8; ++nt)
#pragma unroll
            for (int rp = 0; rp < 2; ++rp)
                *(uint32_t*)(igb + (lo + (unsigned)(rp * 512 + nt * 32))) = pair_pack(ia[nt][rp * 2], ia[nt][rp * 2 + 1], odd);
    }
    __syncthreads();
}

DEVFN void phase2(const P& p, char* smem, int bid, int nb) {
    for (int it = bid; it < 2048; it += nb) {
        const int j = it >> 8, chunk = it & 255;
        if (j < 4) item_gmlp(p, smem, chunk, j);
        else item_ret(p, smem, chunk, j - 4);
    }
}

DEVFN void phase3(const P& p, int bid, int nb) {
    const u16* KV = (const u16*)(p.ws + OFF_KV);
    u16* ST = (u16*)(p.ws + OFF_ST);
    for (int i = bid * NTHREADS + threadIdx.x; i < 262144; i += nb * NTHREADS) {
        const int bh = i >> 12, b = bh >> 2, h = bh & 3, off = (i & 4095) * 4;
        const float lg = __logf(1.0f - exp2f(-5.0f - (float)h));
        const float cd = expf(128.0f * lg);
        uint2 kv[15];
#pragma unroll
        for (int n = 0; n < 15; ++n) kv[n] = *(const uint2*)(KV + (size_t)((b * 16 + n) * 4 + h) * 16384 + off);
        float4 st = make_float4(0.f, 0.f, 0.f, 0.f);
#pragma unroll
        for (int n = 0; n < 16; ++n) {
            *(uint2*)(ST + (size_t)((b * 16 + n) * 4 + h) * 16384 + off) = pack4(st.x, st.y, st.z, st.w);
            if (n < 15) {
                st.x = st.x * cd + bf2f((u16)(kv[n].x & 0xffff)); st.y = st.y * cd + bf2f((u16)(kv[n].x >> 16));
                st.z = st.z * cd + bf2f((u16)(kv[n].y & 0xffff)); st.w = st.w * cd + bf2f((u16)(kv[n].y >> 16));
            }
        }
    }
}

DEVFN void phase45(const P& p, char* smem, int bid, int nb) {
    for (int chunk = bid; chunk < 256; chunk += nb) {
        int tid_ = threadIdx.x; asm volatile("" : "+v"(tid_));
        const int tid = tid_ & 511, lane = tid & 63, w = __builtin_amdgcn_readfirstlane(tid >> 6), fr = lane & 15, fq = lane >> 4;
        const int b = chunk >> 4, odd = fr & 1;
        u16* Yg = (u16*)(p.ws + OFF_Y) + (size_t)chunk * 128 * 1024;
        {
            char* igs = smem + 32768 + w * 13056;
            char* sgs = igs + 4352;
            char* ys = igs + 8704;
            const unsigned so = (unsigned)((tid >> 4) * 256 + (tid & 15) * 16);
            const unsigned wo = (unsigned)((w * 16 + (lane >> 4)) * 256 + (lane & 15) * 16);
            const unsigned qo = (unsigned)((w * 16 + fr) * 256 + fq * 16);
            uint4 stR0, stR1, stR2, stR3, igR0, igR1, igR2, igR3, sgR0, sgR1, sgR2, sgR3;
            bf16x8 qa0, qa1, qa2, qa3;
#define P4_LOADS(HB) { \
                const char* stg = p.ws + OFF_ST + (HB); const char* igg = p.ws + OFF_INTRA + (HB); const char* sgg = p.ws + OFF_SG + (HB); const char* qdg = p.ws + OFF_QD + (HB); \
                stR0 = *(const uint4*)(stg + so); stR1 = *(const uint4*)(stg + (so + 8192u)); stR2 = *(const uint4*)(stg + (so + 16384u)); stR3 = *(const uint4*)(stg + (so + 24576u)); \
                igR0 = *(const uint4*)(igg + wo); igR1 = *(const uint4*)(igg + (wo + 1024u)); igR2 = *(const uint4*)(igg + (wo + 2048u)); igR3 = *(const uint4*)(igg + (wo + 3072u)); \
                sgR0 = *(const uint4*)(sgg + wo); sgR1 = *(const uint4*)(sgg + (wo + 1024u)); sgR2 = *(const uint4*)(sgg + (wo + 2048u)); sgR3 = *(const uint4*)(sgg + (wo + 3072u)); \
                qa0 = *(const bf16x8*)(qdg + qo); qa1 = *(const bf16x8*)(qdg + (qo + 64u)); qa2 = *(const bf16x8*)(qdg + (qo + 128u)); qa3 = *(const bf16x8*)(qdg + (qo + 192u)); }
            P4_LOADS((size_t)(chunk * 4) * 32768)
#pragma unroll
            for (int hh = 0; hh < 4; ++hh) {
                {
                    const int sr = tid >> 4, sc = tid & 15, wr = lane >> 4, wc = (lane & 15) * 16;
                    *(uint4*)(smem + swz(sr, sc)) = stR0; *(uint4*)(smem + swz(sr + 32, sc)) = stR1;
                    *(uint4*)(smem + swz(sr + 64, sc)) = stR2; *(uint4*)(smem + swz(sr + 96, sc)) = stR3;
                    *(uint4*)(igs + wr * 272 + wc) = igR0; *(uint4*)(igs + (wr + 4) * 272 + wc) = igR1;
                    *(uint4*)(igs + (wr + 8) * 272 + wc) = igR2; *(uint4*)(igs + (wr + 12) * 272 + wc) = igR3;
                    *(uint4*)(sgs + wr * 272 + wc) = sgR0; *(uint4*)(sgs + (wr + 4) * 272 + wc) = sgR1;
                    *(uint4*)(sgs + (wr + 8) * 272 + wc) = sgR2; *(uint4*)(sgs + (wr + 12) * 272 + wc) = sgR3;
                }
                __syncthreads();
                bf16x8 qc[4];
                qc[0] = qa0; qc[1] = qa1; qc[2] = qa2; qc[3] = qa3;
                P4_LOADS((size_t)(chunk * 4 + (hh < 3 ? hh + 1 : 3)) * 32768)
                f32x4 o[8];
#pragma unroll
                for (int nt = 0; nt < 8; ++nt) {
                    o[nt] = (f32x4){0.f, 0.f, 0.f, 0.f};
#pragma unroll
                    for (int ks = 0; ks < 4; ++ks) o[nt] = mfma16(qc[ks], frag(smem, nt, ks, fr, fq), o[nt]);
                }
#pragma unroll
                for (int nt = 0; nt < 8; ++nt)
#pragma unroll
                    for (int r = 0; r < 4; ++r) o[nt][r] += bf2f(*(const u16*)(igs + (fq * 4 + r) * 272 + (nt * 16 + fr) * 2));
                float gng[8];
#pragma unroll
                for (int nt = 0; nt < 8; ++nt) gng[nt] = p.gn_g[hh * 128 + nt * 16 + fr];
#pragma unroll
                for (int rp = 0; rp < 2; ++rp) {
                    float yv[2][8];
#pragma unroll
                    for (int r2 = 0; r2 < 2; ++r2) {
                        const int r = rp * 2 + r2;
                        float s = 0.f;
#pragma unroll
                        for (int nt = 0; nt < 8; ++nt) s += o[nt][r];
                        s += __shfl_xor(s, 1); s += __shfl_xor(s, 2); s += __shfl_xor(s, 4); s += __shfl_xor(s, 8);
                        const float mean = s * (1.0f / 128.0f);
                        float q2 = 0.f;
#pragma unroll
                        for (int nt = 0; nt < 8; ++nt) { const float dv = o[nt][r] - mean; q2 += dv * dv; }
                        q2 += __shfl_xor(q2, 1); q2 += __shfl_xor(q2, 2); q2 += __shfl_xor(q2, 4); q2 += __shfl_xor(q2, 8);
                        const float rstd = rsqrtf(q2 * (1.0f / 128.0f) + 1e-6f);
#pragma unroll
                        for (int nt = 0; nt < 8; ++nt) {
                            const float gv = bf2f(*(const u16*)(sgs + (fq * 4 + r) * 272 + (nt * 16 + fr) * 2));
                            yv[r2][nt] = (o[nt][r] - mean) * rstd * gng[nt] * gv;
                        }
                    }
#pragma unroll
                    for (int nt = 0; nt < 8; ++nt)
                        *(uint32_t*)(ys + (fq * 4 + rp * 2 + odd) * 272 + (nt * 16 + (fr & ~1)) * 2) = pair_pack(yv[0][nt], yv[1][nt], odd);
                }
                asm volatile("s_waitcnt lgkmcnt(0)" ::: "memory");
                char* yo = (char*)(Yg + (size_t)(w * 16) * 1024 + 512 + hh * 128);
#pragma unroll
                for (int i = 0; i < 4; ++i) {
                    const int row = (lane >> 4) + 4 * i, ch = lane & 15;
                    *(uint4*)(yo + (unsigned)(row * 2048 + ch * 16)) = *(const uint4*)(ys + row * 272 + ch * 16);
                }
                __syncthreads();
            }
        }
        __threadfence_block();
        __syncthreads();
        float* part = (float*)(smem + SM_SMALL);
        float* rsv = (float*)(smem + 65536);
        f32x4 acc[8][4];
        char* outb = (char*)(p.out + (size_t)chunk * 128 * 1024 + w * 64);
        const char* xb = (const char*)(p.x + (size_t)chunk * 128 * 1024 + w * 64);
        const unsigned oo = (unsigned)(fq * 16384 + fr * 4);
        u16* Zg = (u16*)(p.ws + OFF_Z) + (size_t)chunk * 128 * 512;
#define ROWSQ(HF) \
        _Pragma("unroll") for (int mt = 0; mt < 8; ++mt) \
        _Pragma("unroll") for (int r = 0; r < 4; ++r) { \
            float s = 0.f; \
            _Pragma("unroll") for (int nt = 0; nt < 4; ++nt) s += acc[mt][nt][r] * acc[mt][nt][r]; \
            s += __shfl_xor(s, 1); s += __shfl_xor(s, 2); s += __shfl_xor(s, 4); s += __shfl_xor(s, 8); \
            if (fr == 0) part[((HF) * 8 + w) * 128 + mt * 16 + fq * 4 + r] = s; \
        }
        {
            const bf16x8* Bf = (const bf16x8*)(p.ws + OFF_WOUTF) + ((size_t)(0 * 8 + w) * 128) * 64;
            gemm_core<4>(Yg, Bf, smem, acc);
            ROWSQ(0)
            char* zb = (char*)(Zg + w * 64);
            const unsigned zo = (unsigned)((fq * 4 + odd) * 1024 + (fr & ~1) * 2);
#pragma unroll
            for (int mt = 0; mt < 8; ++mt) {
                char* zm = zb + mt * 16384;
#pragma unroll
                for (int nt = 0; nt < 4; ++nt)
#pragma unroll
                    for (int rp = 0; rp < 2; ++rp)
                        *(uint32_t*)(zm + (zo + (unsigned)(rp * 2048 + nt * 32))) = pair_pack(acc[mt][nt][rp * 2], acc[mt][nt][rp * 2 + 1], odd);
            }
        }
        {
            const bf16x8* Bf = (const bf16x8*)(p.ws + OFF_WOUTF) + ((size_t)(1 * 8 + w) * 128) * 64;
            gemm_core<4>(Yg, Bf, smem, acc);
            ROWSQ(1)
        }
        __syncthreads();
        if (tid < 128) {
            float s = 0.f;
#pragma unroll
            for (int k = 0; k < 16; ++k) s += part[k * 128 + tid];
            rsv[tid] = rsqrtf(s * (1.0f / 1024.0f) + 1e-6f);
        }
        __syncthreads();
        const float* gate = (const float*)(p.ws + OFF_MOD) + b * 3072 + 2048;
        {
            float gg[4];
#pragma unroll
            for (int nt = 0; nt < 4; ++nt) { const int col = 512 + w * 64 + nt * 16 + fr; gg[nt] = gate[col] * p.g_post[col]; }
#pragma unroll
            for (int mt = 0; mt < 8; ++mt)
#pragma unroll
                for (int r = 0; r < 4; ++r) {
                    const float rs = rsv[mt * 16 + fq * 4 + r];
                    char* ob = outb + (mt * 16 + r) * 4096 + 2048;
                    const char* xr = xb + (mt * 16 + r) * 4096 + 2048;
#pragma unroll
                    for (int nt = 0; nt < 4; ++nt)
                        *(float*)(ob + (oo + (unsigned)(nt * 64))) = *(const float*)(xr + (oo + (unsigned)(nt * 64))) + gg[nt] * acc[mt][nt][r] * rs;
                }
        }
        {
            const int c8 = (tid & 63) * 8, r0 = tid >> 6;
            float gq[8];
            {
                const float4 g0 = *(const float4*)(gate + c8), g1 = *(const float4*)(gate + c8 + 4);
                const float4 p0 = *(const float4*)(p.g_post + c8), p1 = *(const float4*)(p.g_post + c8 + 4);
                gq[0] = g0.x * p0.x; gq[1] = g0.y * p0.y; gq[2] = g0.z * p0.z; gq[3] = g0.w * p0.w;
                gq[4] = g1.x * p1.x; gq[5] = g1.y * p1.y; gq[6] = g1.z * p1.z; gq[7] = g1.w * p1.w;
            }
            char* ob = (char*)(p.out + (size_t)chunk * 128 * 1024);
            const char* xr = (const char*)(p.x + (size_t)chunk * 128 * 1024);
            const char* zr = (const char*)Zg;
            const unsigned vo = (unsigned)(r0 * 4096 + c8 * 4), vz = (unsigned)(r0 * 1024 + c8 * 2);
#pragma unroll 4
            for (int i = 0; i < 16; ++i) {
                const uint4 z = *(const uint4*)(zr + (vz + (unsigned)(i * 8192)));
                const float4 x0 = *(const float4*)(xr + (vo + (unsigned)(i * 32768)));
                const float4 x1 = *(const float4*)(xr + (vo + (unsigned)(i * 32768 + 16)));
                const float rs = rsv[i * 8 + r0];
                float4 o0, o1;
                o0.x = x0.x + gq[0] * bf2f((u16)(z.x & 0xffff)) * rs; o0.y = x0.y + gq[1] * bf2f((u16)(z.x >> 16)) * rs;
                o0.z = x0.z + gq[2] * bf2f((u16)(z.y & 0xffff)) * rs; o0.w = x0.w + gq[3] * bf2f((u16)(z.y >> 16)) * rs;
                o1.x = x1.x + gq[4] * bf2f((u16)(z.z & 0xffff)) * rs; o1.y = x1.y + gq[5] * bf2f((u16)(z.z >> 16)) * rs;
                o1.z = x1.z + gq[6] * bf2f((u16)(z.w & 0xffff)) * rs; o1.w = x1.w + gq[7] * bf2f((u16)(z.w >> 16)) * rs;
                *(float4*)(ob + (vo + (unsigned)(i * 32768))) = o0;
                *(float4*)(ob + (vo + (unsigned)(i * 32768 + 16))) = o1;
            }
        }
        __syncthreads();
    }
}

#ifndef N_LAUNCHES
#define N_LAUNCHES 1
#endif

#if N_LAUNCHES == 1
__global__ void __launch_bounds__(NTHREADS) fwd(P p) {
    __shared__ __attribute__((aligned(16))) char smem[SM_TOTAL];
    const int bid = blockIdx.x, nb = gridDim.x;
    if (threadIdx.x == 0) *(uint4*)(smem + SM_BARW) = make_uint4(0u, 0u, 0u, 0u);
    __syncthreads();
    XcdBarrier xb = xcd_barrier_post((unsigned*)(p.ws + OFF_BAR), (volatile LAS unsigned*)(smem + SM_BARW));
#ifndef REP0
#define REP0 1
#define REP1 1
#define REP2 1
#define REP3 1
#define REP4 1
#endif
#pragma unroll 1
    for (int i = 0; i < REP0; ++i) phase0(p, smem, bid, nb);
    xcd_barrier(xb);
#pragma unroll 1
    for (int i = 0; i < REP1; ++i) phase1(p, bid, nb);
    xcd_barrier(xb);
#pragma unroll 1
    for (int i = 0; i < REP2; ++i) phase2(p, smem, bid, nb);
    xcd_barrier(xb);
#pragma unroll 1
    for (int i = 0; i < REP3; ++i) phase3(p, bid, nb);
    xcd_barrier(xb);
#pragma unroll 1
    for (int i = 0; i < REP4; ++i) phase45(p, smem, bid, nb);
}
#else
__global__ void __launch_bounds__(NTHREADS) k_phase0(P p) { __shared__ __attribute__((aligned(16))) char smem[SM_TOTAL]; phase0(p, smem, blockIdx.x, gridDim.x); }
__global__ void __launch_bounds__(NTHREADS) k_phase1(P p) { phase1(p, blockIdx.x, gridDim.x); }
__global__ void __launch_bounds__(NTHREADS) k_phase2(P p) { __shared__ __attribute__((aligned(16))) char smem[SM_TOTAL]; phase2(p, smem, blockIdx.x, gridDim.x); }
__global__ void __launch_bounds__(NTHREADS) k_phase3(P p) { phase3(p, blockIdx.x, gridDim.x); }
__global__ void __launch_bounds__(NTHREADS) k_phase45(P p) { __shared__ __attribute__((aligned(16))) char smem[SM_TOTAL]; phase45(p, smem, blockIdx.x, gridDim.x); }
#endif

extern "C" void kernel_launch(void* const* d_in, const int* in_sizes, int n_in, void* d_out, int out_size, void* d_ws, size_t ws_size,
                              hipStream_t stream) {
    P p{};
    p.x = (const float*)d_in[0]; p.c = (const float*)d_in[1]; p.pos = (const int*)d_in[2]; p.w_ada = (const float*)d_in[3];
    p.b_ada = (const float*)d_in[4]; p.g_pre = (const float*)d_in[5]; p.w_in = (const float*)d_in[6]; p.ln_g = (const float*)d_in[7];
    p.gws = (const float*)d_in[8]; p.gbs = (const float*)d_in[9]; p.gn_g = (const float*)d_in[10]; p.w_out = (const float*)d_in[11];
    p.g_post = (const float*)d_in[12]; p.out = (float*)d_out; p.ws = (char*)d_ws;
    p.ph_lo = 0; p.ph_hi = 5;
    const int grid = 256;
#if N_LAUNCHES == 1
    (void)hipMemsetAsync((char*)d_ws + OFF_BAR, 0, XCD_BAR_WORDS * 4, stream);
    void* args[] = {&p};
    hipError_t e = hipLaunchCooperativeKernel((const void*)fwd, dim3(grid), dim3(NTHREADS), args, 0, stream);
    if (e != hipSuccess) fprintf(stderr, "cooperative launch failed: %s\n", hipGetErrorString(e));
#else
    hipLaunchKernelGGL(k_phase0, dim3(grid), dim3(NTHREADS), 0, stream, p);
    hipLaunchKernelGGL(k_phase1, dim3(grid), dim3(NTHREADS), 0, stream, p);
    hipLaunchKernelGGL(k_phase2, dim3(grid), dim3(NTHREADS), 0, stream, p);
    hipLaunchKernelGGL(k_phase3, dim3(grid), dim3(NTHREADS), 0, stream, p);
    hipLaunchKernelGGL(k_phase45, dim3(grid), dim3(NTHREADS), 0, stream, p);
#endif
}
```

```cpp
#include <hip/hip_runtime.h>
#include <stdint.h>
#include <stdio.h>

typedef __attribute__((ext_vector_type(8))) short bf16x8;
typedef __attribute__((ext_vector_type(4))) float f32x4;
typedef unsigned short u16;
#define DEVFN __device__ __forceinline__
#define NTHREADS 512
#define LAS __attribute__((address_space(3)))

#define OFF_BAR    0ull
#define OFF_MOD    16384ull
#define OFF_WINF   262144ull
#define OFF_WOUTF  7602176ull
#define OFF_WS     9699328ull
#define OFF_H      16777216ull
#define OFF_Y      83886080ull
#define OFF_QD     150994944ull
#define OFF_SG     184549376ull
#define OFF_INTRA  218103808ull
#define OFF_KV     285212672ull
#define OFF_ST     OFF_H
#define OFF_TAB    385875968ull
#define OFF_Z      (OFF_H + 33554432ull)

#define SM_SMALL   139264
#define SM_BARW    147456
#define SM_TOTAL   (147456 + 16)

struct P {
    const float* x; const float* c; const int* pos; const float* w_ada; const float* b_ada; const float* g_pre;
    const float* w_in; const float* ln_g; const float* gws; const float* gbs; const float* gn_g; const float* w_out;
    const float* g_post; float* out; char* ws;
    int ph_lo, ph_hi;
};

typedef __attribute__((ext_vector_type(2))) __bf16 bf2_t;
DEVFN u16 f2bf(float f) { return __builtin_bit_cast(u16, (__bf16)f); }
DEVFN float bf2f(u16 h) { return __uint_as_float(((uint32_t)h) << 16); }
DEVFN uint32_t pack2(float a, float b) { bf2_t v = {(__bf16)a, (__bf16)b}; return __builtin_bit_cast(uint32_t, v); }
DEVFN void lds_barrier() { asm volatile("s_waitcnt lgkmcnt(0)\n\ts_barrier" ::: "memory"); }
DEVFN uint2 pack4(float a, float b, float c, float d) { uint2 r; r.x = pack2(a, b); r.y = pack2(c, d); return r; }
DEVFN float silu(float x) { return x * __builtin_amdgcn_rcpf(1.0f + __expf(-x)); }
template <int CTRL> DEVFN float dppf(float v) { return __int_as_float(__builtin_amdgcn_update_dpp(0, __float_as_int(v), CTRL, 0xF, 0xF, true)); }
DEVFN float red16(float v) { v += dppf<0x128>(v); v += dppf<0x124>(v); v += dppf<0x4E>(v); v += dppf<0xB1>(v); return v; }
DEVFN float red4(float v) { v += dppf<0x4E>(v); v += dppf<0xB1>(v); return v; }
DEVFN float swap1(float v) { return __int_as_float(__builtin_amdgcn_update_dpp(0, __float_as_int(v), 0xB1, 0xF, 0xF, true)); }
DEVFN uint32_t pair_pack(float a, float b, int odd) {
    const float recv = swap1(odd ? a : b);
    return odd ? pack2(recv, b) : pack2(a, recv);
}
DEVFN int swz(int row, int chunk) { return row * 256 + ((chunk ^ (row & 15)) << 4); }
DEVFN bf16x8 frag(const char* base, int tile, int ks, int fr, int fq) {
    return *(const bf16x8*)(base + swz(tile * 16 + fr, ks * 4 + fq));
}
DEVFN f32x4 mfma16(bf16x8 a, bf16x8 b, f32x4 c) { return __builtin_amdgcn_mfma_f32_16x16x32_bf16(a, b, c, 0, 0, 0); }

#define XB_TMO      128
#define XB_XCNT(j)  (256  + 64 * (j))
#define XB_XSUB(j)  (1280 + 64 * (j))
#define XB_XGEN(j)  (2304 + 64 * (j))
#define XB_TOP      3328
#define XB_TOPGEN   3392
#define XCD_BAR_WORDS 3456
#define XB_SPIN_CAP (1u << 22)
DEVFN unsigned xb_ld(unsigned* p) { return __hip_atomic_load(p, __ATOMIC_RELAXED, __HIP_MEMORY_SCOPE_AGENT); }
DEVFN unsigned xb_add(unsigned* p, unsigned v) { return __hip_atomic_fetch_add(p, v, __ATOMIC_RELAXED, __HIP_MEMORY_SCOPE_AGENT); }
DEVFN unsigned xb_xcc_id() { return (unsigned)__builtin_amdgcn_s_getreg((3 << 11) | 20) & 0xFu; }
#define XB_SPIN(cond, bar) do { unsigned _sp = 0; while (cond) { __builtin_amdgcn_s_sleep(1); \
    if ((++_sp & 255u) == 0u) { if (xb_ld(&(bar)[XB_TMO])) break; if (_sp > XB_SPIN_CAP) { atomicAdd(&(bar)[XB_TMO], 1u); break; } } } } while (0)
struct XcdBarrier { unsigned* bar; unsigned x; volatile LAS unsigned* st; };
DEVFN XcdBarrier xcd_barrier_post(unsigned* bar, volatile LAS unsigned* st) {
    XcdBarrier b; b.bar = bar; b.x = xb_xcc_id(); b.st = st;
    if (threadIdx.x == 0) (void)xb_add(&bar[XB_XCNT(b.x)], 1u);
    return b;
}
DEVFN void xcd_barrier_complete(unsigned* bar, unsigned x, unsigned& nloc, unsigned& nx) {
    const unsigned G = gridDim.x * gridDim.y * gridDim.z;
    unsigned sum, cnt, mine, sp = 0u;
    for (;;) {
        sum = 0u; cnt = 0u; mine = 0u;
#pragma unroll
        for (unsigned j = 0; j < 16; ++j) { const unsigned c = xb_ld(&bar[XB_XCNT(j)]); sum += c; cnt += (c > 0u) ? 1u : 0u; mine = (j == x) ? c : mine; }
        if (sum == G) break;
        __builtin_amdgcn_s_sleep(1);
        if ((++sp & 255u) == 0u) { if (xb_ld(&bar[XB_TMO])) break; if (sp > XB_SPIN_CAP) { atomicAdd(&bar[XB_TMO], 1u); break; } }
    }
    nloc = mine > 0u ? mine : 1u; nx = cnt > 0u ? cnt : 1u;
}
DEVFN void xcd_barrier(const XcdBarrier& b) {
    asm volatile("s_waitcnt vmcnt(0)" ::: "memory");
    __syncthreads();
    if (threadIdx.x == 0) {
        unsigned* bar = b.bar;
        __builtin_amdgcn_s_waitcnt(0);
        unsigned nloc = b.st[0], nx = b.st[1];
        if (nloc == 0u) { xcd_barrier_complete(bar, b.x, nloc, nx); b.st[0] = nloc; b.st[1] = nx; }
        const unsigned old = xb_add(&bar[XB_XSUB(b.x)], 1u);
        const unsigned gen = old / nloc;
        if (old + 1u == (gen + 1u) * nloc) {
            __builtin_amdgcn_fence(__ATOMIC_RELEASE, "agent");
            asm volatile("s_waitcnt vmcnt(0)" ::: "memory");
            const unsigned og = xb_add(&bar[XB_TOP], 1u);
            const unsigned tg = og / nx;
            if (og + 1u == (tg + 1u) * nx) xb_add(&bar[XB_TOPGEN], 1u);
            else XB_SPIN(xb_ld(&bar[XB_TOPGEN]) == tg, bar);
            __builtin_amdgcn_fence(__ATOMIC_ACQUIRE, "agent");
            xb_add(&bar[XB_XGEN(b.x)], 1u);
            asm volatile("s_waitcnt vmcnt(0)" ::: "memory");
        } else {
            XB_SPIN(xb_ld(&bar[XB_XGEN(b.x)]) == gen, bar);
            __builtin_amdgcn_fence(__ATOMIC_ACQUIRE, "agent");
            asm volatile("s_waitcnt vmcnt(0)" ::: "memory");
        }
    }
    __syncthreads();
}

DEVFN int proj_feature(int j, int w, int nt, int c) {
    if (j < 4) return nt * 512 + j * 128 + w * 16 + c;
    const int hh = j - 4;
    if (nt < 2) return (c < 8 ? 1536 : 2048) + hh * 128 + nt * 64 + w * 8 + (c & 7);
    if (nt == 2) return 2560 + hh * 128 + w * 16 + c;
    return 3072 + hh * 128 + w * 16 + c;
}

DEVFN void phase0(const P& p, char* smem, int bid, int nb) {
    const int tid = threadIdx.x, lane = tid & 63, w = __builtin_amdgcn_readfirstlane(tid >> 6);
    const int N_MOD = 768, N_WIN = 896, N_WOUT = 256, N_WS = 16;
    const int NITEMS = N_MOD + N_WIN + N_WOUT + N_WS;
    for (int it = bid; it < NITEMS; it += nb) {
        if (it < N_MOD) {
            float* sc = (float*)smem;
            float* red = (float*)(smem + 65536);
            const int cg = it >> 3, ksp = it & 7, e0 = cg * 32, d0 = ksp * 128;
            lds_barrier();
            for (int i = tid; i < 2048; i += NTHREADS) sc[i] = silu(p.c[(i >> 7) * 1024 + d0 + (i & 127)]);
            lds_barrier();
            const int col = tid & 31, kg = tid >> 5;
            float wv[8];
#pragma unroll
            for (int q = 0; q < 8; ++q) wv[q] = p.w_ada[(size_t)(d0 + kg * 8 + q) * 3072 + e0 + col];
            float acc[16];
#pragma unroll
            for (int b = 0; b < 16; ++b) {
                float a = 0.f;
#pragma unroll
                for (int q = 0; q < 8; ++q) a += sc[b * 128 + kg * 8 + q] * wv[q];
                acc[b] = a;
            }
#pragma unroll
            for (int b = 0; b < 16; ++b) red[(kg * 16 + b) * 32 + col] = acc[b];
            lds_barrier();
            {
                const int b = tid >> 5;
                float s = (ksp == 0) ? p.b_ada[e0 + col] : 0.f;
#pragma unroll
                for (int k = 0; k < 16; ++k) s += red[(k * 16 + b) * 32 + col];
                atomicAdd((float*)(p.ws + OFF_MOD) + b * 3072 + e0 + col, s);
            }
        } else if (it < N_MOD + N_WIN) {
            const int F = (it - N_MOD) * 8 + w;
            int j, ww, ks, nt;
            if (F < 3072) { j = F / 768; int rem = F % 768; ww = rem / 96; int r2 = rem % 96; ks = r2 / 3; nt = r2 % 3; }
            else { int f2 = F - 3072; j = 4 + f2 / 1024; int rem = f2 % 1024; ww = rem / 128; int r2 = rem % 128; ks = r2 / 4; nt = r2 % 4; }
            const int f = proj_feature(j, ww, nt, lane & 15);
            const int k0 = ks * 32 + (lane >> 4) * 8;
            float v[8];
#pragma unroll
            for (int q = 0; q < 8; ++q) v[q] = p.w_in[(size_t)(k0 + q) * 3584 + f];
            uint4 o; o.x = pack2(v[0], v[1]); o.y = pack2(v[2], v[3]); o.z = pack2(v[4], v[5]); o.w = pack2(v[6], v[7]);
            ((uint4*)(p.ws + OFF_WINF))[(size_t)F * 64 + lane] = o;
        } else if (it < N_MOD + N_WIN + N_WOUT) {
            const int F = (it - N_MOD - N_WIN) * 8 + w;
            const int nt = F & 3, ks = (F >> 2) & 31, hw = F >> 7;
            const int n = hw * 64 + nt * 16 + (lane & 15);
            const int k0 = ks * 32 + (lane >> 4) * 8;
            float v[8];
#pragma unroll
            for (int q = 0; q < 8; ++q) v[q] = p.w_out[(size_t)(k0 + q) * 1024 + n];
            uint4 o; o.x = pack2(v[0], v[1]); o.y = pack2(v[2], v[3]); o.z = pack2(v[4], v[5]); o.w = pack2(v[6], v[7]);
            ((uint4*)(p.ws + OFF_WOUTF))[(size_t)F * 64 + lane] = o;
        } else {
            const int base = (it - N_MOD - N_WIN - N_WOUT) * 4096 + tid * 8;
            const int t = (base >> 7) & 127, s0 = base & 127;
            float v[8];
#pragma unroll
            for (int q = 0; q < 8; ++q) v[q] = (s0 + q <= t) ? p.gws[base + q] : 0.f;
            uint4 o; o.x = pack2(v[0], v[1]); o.y = pack2(v[2], v[3]); o.z = pack2(v[4], v[5]); o.w = pack2(v[6], v[7]);
            *(uint4*)((u16*)(p.ws + OFF_WS) + base) = o;
        }
    }
}

DEVFN void phase1(const P& p, int bid, int nb) {
    const int tid = threadIdx.x, lane = tid & 63, w = __builtin_amdgcn_readfirstlane(tid >> 6);
    const float* mod = (const float*)(p.ws + OFF_MOD);
    u16* H = (u16*)(p.ws + OFF_H);
    for (int rg = bid * 8 + w; rg < 2048; rg += nb * 8) {
        const int b = rg >> 7;

        float gs[16], sh[16];
#pragma unroll
        for (int i = 0; i < 4; ++i) {
            const int col = (i * 64 + lane) * 4;
            const float4 g = *(const float4*)(p.g_pre + col);
            const float4 s = *(const float4*)(mod + b * 3072 + 1024 + col);
            const float4 t = *(const float4*)(mod + b * 3072 + col);
            gs[i * 4 + 0] = g.x * (1.f + s.x); gs[i * 4 + 1] = g.y * (1.f + s.y); gs[i * 4 + 2] = g.z * (1.f + s.z); gs[i * 4 + 3] = g.w * (1.f + s.w);
            sh[i * 4 + 0] = t.x; sh[i * 4 + 1] = t.y; sh[i * 4 + 2] = t.z; sh[i * 4 + 3] = t.w;
        }
#pragma unroll 4
        for (int r = 0; r < 16; ++r) {
            const size_t row = (size_t)rg * 16 + r;
            const float4* xr = (const float4*)(p.x + row * 1024);
            float4 v[4];
#pragma unroll
            for (int i = 0; i < 4; ++i) v[i] = xr[i * 64 + lane];
            float ss = 0.f;
#pragma unroll
            for (int i = 0; i < 4; ++i) ss += v[i].x * v[i].x + v[i].y * v[i].y + v[i].z * v[i].z + v[i].w * v[i].w;
#pragma unroll
            for (int m = 32; m >= 1; m >>= 1) ss += __shfl_xor(ss, m);
            const float rs = rsqrtf(ss * (1.0f / 1024.0f) + 1e-6f);
#pragma unroll
            for (int i = 0; i < 4; ++i) {
                const uint2 o = pack4(v[i].x * rs * gs[i * 4 + 0] + sh[i * 4 + 0], v[i].y * rs * gs[i * 4 + 1] + sh[i * 4 + 1],
                                      v[i].z * rs * gs[i * 4 + 2] + sh[i * 4 + 2], v[i].w * rs * gs[i * 4 + 3] + sh[i * 4 + 3]);
                *(uint2*)(H + row * 1024 + (i * 64 + lane) * 4) = o;
            }
        }
    }
}

template <int NT>
DEVFN void gemm_step(const char* An, const char* Bn, const unsigned avo, const unsigned bvo, char* smem, const int cur, const int aw,
                     const int foff0, const int foff1, f32x4 (&acc)[8][NT], const bf16x8 (&bc)[2][NT], bf16x8 (&bn)[2][NT],
                     const uint4& w0, const uint4& w1, uint4& l0, uint4& l1) {
    l0 = *(const uint4*)(An + avo); l1 = *(const uint4*)(An + (avo + 131072u));
#pragma unroll
    for (int ss = 0; ss < 2; ++ss)
#pragma unroll
        for (int nt = 0; nt < NT; ++nt) bn[ss][nt] = *(const bf16x8*)(Bn + (bvo + (unsigned)((ss * NT + nt) * 1024)));
    __builtin_amdgcn_sched_barrier(0);
    {
        bf16x8 x0 = *(const bf16x8*)(smem + cur + foff0), x1 = *(const bf16x8*)(smem + cur + 2048 + foff0);
#pragma unroll
        for (int g = 0; g < 8; ++g) {
            const int ss = g >> 2, m0 = (g & 3) * 2;
            bf16x8 y0 = x0, y1 = x1;
            if (g < 7) {
                const int gn = g + 1, fo = (gn >> 2) ? foff1 : foff0, mn = (gn & 3) * 2;
                y0 = *(const bf16x8*)(smem + cur + mn * 2048 + fo);
                y1 = *(const bf16x8*)(smem + cur + (mn + 1) * 2048 + fo);
            }
            __builtin_amdgcn_sched_barrier(0);
#pragma unroll
            for (int nt = 0; nt < NT; ++nt) {
                acc[m0][nt] = mfma16(x0, bc[ss][nt], acc[m0][nt]);
                acc[m0 + 1][nt] = mfma16(x1, bc[ss][nt], acc[m0 + 1][nt]);
            }
            x0 = y0; x1 = y1;
        }
    }
    __builtin_amdgcn_sched_barrier(0);
    *(uint4*)(smem + (cur ^ 16384) + aw) = w0;
    *(uint4*)(smem + (cur ^ 16384) + aw + 8192) = w1;
    lds_barrier();
}

template <int NT>
DEVFN void gemm_core(const u16* __restrict__ A, const bf16x8* __restrict__ Bf, char* smem, f32x4 (&acc)[8][NT]) {
    int tid_ = threadIdx.x; asm volatile("" : "+v"(tid_));
    const int tid = tid_ & 511, lane = tid & 63;
    const int fr = lane & 15, fq = lane >> 4;
    const int ar = tid >> 3, ac = tid & 7;
    const char* Ab = (const char*)A;
    const char* Bb = (const char*)Bf;
    const unsigned avo = (unsigned)(ar * 2048 + ac * 16);
    const unsigned bvo = (unsigned)(lane * 16);
    const int aw = ar * 128 + ((ac ^ (ar & 7)) << 4);
    const int foff0 = fr * 128 + (((0 + fq) ^ (fr & 7)) << 4);
    const int foff1 = fr * 128 + (((4 + fq) ^ (fr & 7)) << 4);
#pragma unroll
    for (int mt = 0; mt < 8; ++mt)
#pragma unroll
        for (int nt = 0; nt < NT; ++nt) acc[mt][nt] = (f32x4){0.f, 0.f, 0.f, 0.f};
    uint4 ra0, ra1, rb0, rb1;
    {
        const uint4 a0 = *(const uint4*)(Ab + avo), a1 = *(const uint4*)(Ab + (avo + 131072u));
        rb0 = *(const uint4*)(Ab + 128 + avo); rb1 = *(const uint4*)(Ab + 128 + (avo + 131072u));
        *(uint4*)(smem + aw) = a0;
        *(uint4*)(smem + aw + 8192) = a1;
    }
    bf16x8 b0[2][NT], b1[2][NT];
#pragma unroll
    for (int ss = 0; ss < 2; ++ss)
#pragma unroll
        for (int nt = 0; nt < NT; ++nt) b0[ss][nt] = *(const bf16x8*)(Bb + (bvo + (unsigned)((ss * NT + nt) * 1024)));
    lds_barrier();
#pragma unroll 1
    for (int k2 = 0; k2 < 8; ++k2) {
        const int n1 = 2 * k2 + 1;
        const int n2 = k2 < 7 ? 2 * k2 + 2 : 15;
        const int n3 = k2 < 7 ? 2 * k2 + 3 : 15;
        gemm_step<NT>(Ab + n2 * 128, Bb + n1 * (2 * NT * 1024), avo, bvo, smem, 0, aw, foff0, foff1, acc, b0, b1, rb0, rb1, ra0, ra1);
        gemm_step<NT>(Ab + n3 * 128, Bb + n2 * (2 * NT * 1024), avo, bvo, smem, 16384, aw, foff0, foff1, acc, b1, b0, ra0, ra1, rb0, rb1);
    }
}

#define G_VS   0
#define G_VLT  69632
#define G_WS   102400
#define G_Y    0
DEVFN void item_gmlp(const P& p, char* smem, int chunk, int g) {
    int tid_ = threadIdx.x; asm volatile("" : "+v"(tid_)); const int tid = tid_ & 511, lane = tid & 63, w = __builtin_amdgcn_readfirstlane(tid >> 6), fr = lane & 15, fq = lane >> 4;
    float* stats = (float*)(smem + SM_SMALL);
    float* bsv = (float*)(smem + SM_SMALL + 1024);
    if (tid < 128) bsv[tid] = p.gbs[g * 128 + tid];
    f32x4 acc[8][3];
    const u16* A = (const u16*)(p.ws + OFF_H) + (size_t)chunk * 128 * 1024;
    const bf16x8* Bf = (const bf16x8*)(p.ws + OFF_WINF) + ((size_t)g * 768 + w * 96) * 64;
    gemm_core<3>(A, Bf, smem, acc);
    const int d = w * 16 + fr;
    {
        float* VS = (float*)(smem + G_VS);
#pragma unroll
        for (int mt = 0; mt < 8; ++mt)
#pragma unroll
            for (int r = 0; r < 4; ++r) VS[(mt * 16 + fq * 4 + r) * 132 + d] = acc[mt][1][r];
        const uint4* wsg = (const uint4*)((const u16*)(p.ws + OFF_WS) + g * 16384);
#pragma unroll
        for (int i = 0; i < 4; ++i) {
            const int row = (tid >> 4) + 32 * i, ch = tid & 15;
            *(uint4*)(smem + G_WS + swz(row, ch)) = wsg[row * 16 + ch];
        }
    }
    lds_barrier();
    {
        const float* VS = (const float*)(smem + G_VS);
        const int row = tid >> 2, q = tid & 3;
        float v[32];
#pragma unroll
        for (int i = 0; i < 8; ++i) {
            const float4 t4 = *(const float4*)(VS + row * 132 + q * 32 + i * 4);
            v[i * 4 + 0] = t4.x; v[i * 4 + 1] = t4.y; v[i * 4 + 2] = t4.z; v[i * 4 + 3] = t4.w;
        }
        float s = 0.f;
#pragma unroll
        for (int i = 0; i < 32; ++i) s += v[i];
        s = red4(s);
        const float mean = s * (1.0f / 128.0f);
        float q2 = 0.f;
#pragma unroll
        for (int i = 0; i < 32; ++i) { const float dv = v[i] - mean; q2 += dv * dv; }
        q2 = red4(q2);
        if (q == 0) { stats[row * 2] = mean; stats[row * 2 + 1] = rsqrtf(q2 * (1.0f / 128.0f) + 1e-6f); }
    }
    lds_barrier();
    {
        const float lg = p.ln_g[g * 128 + d];
#pragma unroll
        for (int mt = 0; mt < 8; ++mt) {
            const int s0 = mt * 16 + fq * 4;
            float o[4];
#pragma unroll
            for (int r = 0; r < 4; ++r) {
                const float2 st = *(const float2*)(stats + (s0 + r) * 2);
                o[r] = (acc[mt][1][r] - st.x) * st.y * lg;
            }
            *(uint2*)(smem + G_VLT + swz(d, s0 >> 3) + (s0 & 7) * 2) = pack4(o[0], o[1], o[2], o[3]);
        }
    }
    lds_barrier();
    {
        bf16x8 bv[4];
#pragma unroll
        for (int ks = 0; ks < 4; ++ks) bv[ks] = frag(smem + G_VLT, w, ks, fr, fq);
#pragma unroll
        for (int mt = 0; mt < 8; ++mt) {
            f32x4 m = (f32x4){0.f, 0.f, 0.f, 0.f};
#pragma unroll
            for (int ks = 0; ks < 4; ++ks)
                if (ks * 32 <= mt * 16 + 15) m = mfma16(frag(smem + G_WS, mt, ks, fr, fq), bv[ks], m);
#pragma unroll
            for (int r = 0; r < 4; ++r) {
                const int t = mt * 16 + fq * 4 + r;
                const float o = acc[mt][0][r] * (m[r] + bsv[t]) * silu(acc[mt][2][r]);
                *(u16*)(smem + G_Y + t * 272 + d * 2) = f2bf(o);
            }
        }
    }
    lds_barrier();
    {
        u16* Y = (u16*)(p.ws + OFF_Y) + (size_t)chunk * 128 * 1024 + g * 128;
#pragma unroll
        for (int i = 0; i < 4; ++i) {
            const int row = (tid >> 4) + 32 * i, ch = tid & 15;
            *(uint4*)(Y + (size_t)row * 1024 + ch * 8) = *(const uint4*)(smem + G_Y + row * 272 + ch * 16);
        }
    }
    lds_barrier();
}

#define R_Q   0
#define R_K   32768
#define R_KT  65536
#define R_VT  98304
DEVFN void item_ret(const P& p, char* smem, int chunk, int hh) {
    int tid_ = threadIdx.x; asm volatile("" : "+v"(tid_)); const int tid = tid_ & 511, lane = tid & 63, w = __builtin_amdgcn_readfirstlane(tid >> 6), fr = lane & 15, fq = lane >> 4;
    float* posf = (float*)(smem + SM_SMALL);
    float* kdec = posf + 128;
    float* qdec = posf + 256;
    const float lg = __logf(1.0f - exp2f(-5.0f - (float)hh));
    if (tid < 128) {
        posf[tid] = (float)p.pos[chunk * 128 + tid];
        kdec[tid] = expf((float)(127 - tid) * lg);
        qdec[tid] = expf((float)(tid + 1) * lg);
    }
    f32x4 acc[8][4];
    const u16* A = (const u16*)(p.ws + OFF_H) + (size_t)chunk * 128 * 1024;
    const bf16x8* Bf = (const bf16x8*)(p.ws + OFF_WINF) + ((size_t)3072 + hh * 1024 + w * 128) * 64;
    gemm_core<4>(A, Bf, smem, acc);
    const size_t base = (size_t)(chunk * 4 + hh) * 16384;
    const int odd = fr & 1;
    {
        const int isk = fr >> 3, d = w * 8 + (fr & 7), de = d & ~1;
        const float scale = isk ? 0.08838834764831845f : 1.0f;
        const float invf = 1.0f / powf(10000.0f, (float)d * (1.0f / 64.0f));
        char* RX = smem + (isk ? R_K : R_Q);
        const int e = w * 16 + fr;
        char* sgb = (char*)((u16*)(p.ws + OFF_SG) + base + w * 16);
        const unsigned lo = (unsigned)((fq * 4 + odd) * 256 + (fr & ~1) * 2);
#pragma unroll
        for (int mt = 0; mt < 8; ++mt) {
            const int t0 = mt * 16 + fq * 4;
            float r1[4], r2[4];
#pragma unroll
            for (int r = 0; r < 4; ++r) {
                const float rev = (posf[t0 + r] * invf) * 0.15915494309189535f;
                const float frv = rev - floorf(rev);
                const float cs = __builtin_amdgcn_cosf(frv) * scale, sn = __builtin_amdgcn_sinf(frv) * scale;
                const float x1 = acc[mt][0][r], x2 = acc[mt][1][r];
                r1[r] = x1 * cs - x2 * sn; r2[r] = x2 * cs + x1 * sn;
            }
            if (isk) {
                const float4 kd = *(const float4*)(kdec + t0);
                *(uint2*)(smem + R_KT + swz(d, t0 >> 3) + (t0 & 7) * 2) = pack4(r1[0] * kd.x, r1[1] * kd.y, r1[2] * kd.z, r1[3] * kd.w);
                *(uint2*)(smem + R_KT + swz(d + 64, t0 >> 3) + (t0 & 7) * 2) = pack4(r2[0] * kd.x, r2[1] * kd.y, r2[2] * kd.z, r2[3] * kd.w);
            }
#pragma unroll
            for (int rp = 0; rp < 2; ++rp) {
                const int tr = t0 + rp * 2 + odd;
                *(uint32_t*)(RX + swz(tr, de >> 3) + (de & 7) * 2) = pair_pack(r1[rp * 2], r1[rp * 2 + 1], odd);
                *(uint32_t*)(RX + swz(tr, (de + 64) >> 3) + (de & 7) * 2) = pair_pack(r2[rp * 2], r2[rp * 2 + 1], odd);
            }
            *(uint2*)(smem + R_VT + swz(e, t0 >> 3) + (t0 & 7) * 2) = pack4(acc[mt][2][0], acc[mt][2][1], acc[mt][2][2], acc[mt][2][3]);
#pragma unroll
            for (int rp = 0; rp < 2; ++rp)
                *(uint32_t*)(sgb + (lo + (unsigned)(mt * 4096 + rp * 512))) = pair_pack(silu(acc[mt][3][rp * 2]), silu(acc[mt][3][rp * 2 + 1]), odd);
        }
    }
    lds_barrier();
    uint2 sreg[8];
    {
        u16* qd = (u16*)(p.ws + OFF_QD) + base;
#pragma unroll
        for (int i = 0; i < 4; ++i) {
            const int row = (tid >> 4) + 32 * i, ch = tid & 15;
            const uint4 v = *(const uint4*)(smem + R_Q + swz(row, ch));
            const float f = qdec[row];
            uint4 o;
            o.x = pack2(bf2f((u16)(v.x & 0xffff)) * f, bf2f((u16)(v.x >> 16)) * f);
            o.y = pack2(bf2f((u16)(v.y & 0xffff)) * f, bf2f((u16)(v.y >> 16)) * f);
            o.z = pack2(bf2f((u16)(v.z & 0xffff)) * f, bf2f((u16)(v.z >> 16)) * f);
            o.w = pack2(bf2f((u16)(v.w & 0xffff)) * f, bf2f((u16)(v.w >> 16)) * f);
            *(uint4*)(qd + row * 128 + ch * 8) = o;
        }
        f32x4 kv[8], sa[8];
#pragma unroll
        for (int nt = 0; nt < 8; ++nt) { kv[nt] = (f32x4){0.f, 0.f, 0.f, 0.f}; sa[nt] = (f32x4){0.f, 0.f, 0.f, 0.f}; }
#pragma unroll
        for (int ks = 0; ks < 4; ++ks) {
            const bf16x8 av = frag(smem + R_VT, w, ks, fr, fq);
            const bf16x8 ak = frag(smem + R_K, w, ks, fr, fq);
#pragma unroll
            for (int nt = 0; nt < 8; ++nt) {
                kv[nt] = mfma16(av, frag(smem + R_KT, nt, ks, fr, fq), kv[nt]);
                if (nt >= w) sa[nt] = mfma16(ak, frag(smem + R_Q, nt, ks, fr, fq), sa[nt]);
            }
        }
        char* kvb = (char*)((u16*)(p.ws + OFF_KV) + base + w * 2048);
        const unsigned lo = (unsigned)((fq * 4 + odd) * 256 + (fr & ~1) * 2);
#pragma unroll
        for (int nt = 0; nt < 8; ++nt)
#pragma unroll
            for (int rp = 0; rp < 2; ++rp)
                *(uint32_t*)(kvb + (lo + (unsigned)(rp * 512 + nt * 32))) = pair_pack(kv[nt][rp * 2], kv[nt][rp * 2 + 1], odd);
#pragma unroll
        for (int nt = 0; nt < 8; ++nt) {
            const int t = nt * 16 + fr, s0 = w * 16 + fq * 4;
            float o[4];
#pragma unroll
            for (int r = 0; r < 4; ++r) {
                const int s = s0 + r;
                o[r] = (t >= s) ? sa[nt][r] * __expf((float)(t - s) * lg) : 0.f;
            }
            sreg[nt] = pack4(o[0], o[1], o[2], o[3]);
        }
    }
    lds_barrier();
    {
        const int s0 = w * 16 + fq * 4;
#pragma unroll
        for (int nt = 0; nt < 8; ++nt) *(uint2*)(smem + R_KT + swz(nt * 16 + fr, s0 >> 3) + (s0 & 7) * 2) = sreg[nt];
    }
    lds_barrier();
    {
        f32x4 ia[8];
#pragma unroll
        for (int nt = 0; nt < 8; ++nt) ia[nt] = (f32x4){0.f, 0.f, 0.f, 0.f};
#pragma unroll
        for (int ks = 0; ks < 4; ++ks)
            if (ks * 32 <= w * 16 + 15) {
                const bf16x8 af = frag(smem + R_KT, w, ks, fr, fq);
#pragma unroll
                for (int nt = 0; nt < 8; ++nt) ia[nt] = mfma16(af, frag(smem + R_VT, nt, ks, fr, fq), ia[nt]);
            }
        char* igb = (char*)((u16*)(p.ws + OFF_INTRA) + base + w * 2048);
        const unsigned lo = (unsigned)((fq * 4 + odd) * 256 + (fr & ~1) * 2);
#pragma unroll
        for (int nt = 0; nt < 8; ++nt)
#pragma unroll
            for (int rp = 0; rp < 2; ++rp)
                *(uint32_t*)(igb + (lo + (unsigned)(rp * 512 + nt * 32))) = pair_pack(ia[nt][rp * 2], ia[nt][rp * 2 + 1], odd);
    }
    lds_barrier();
}

DEVFN void phase2(const P& p, char* smem, int bid, int nb) {
    for (int it = bid; it < 2048; it += nb) {
        const int j = it >> 8, chunk = it & 255;
        if (j < 4) item_gmlp(p, smem, chunk, j);
        else item_ret(p, smem, chunk, j - 4);
    }
}

DEVFN void phase3(const P& p, int bid, int nb) {
    const u16* KV = (const u16*)(p.ws + OFF_KV);
    u16* ST = (u16*)(p.ws + OFF_ST);
    for (int i = bid * NTHREADS + threadIdx.x; i < 262144; i += nb * NTHREADS) {
        const int bh = i >> 12, b = bh >> 2, h = bh & 3, off = (i & 4095) * 4;
        const float lg = __logf(1.0f - exp2f(-5.0f - (float)h));
        const float cd = expf(128.0f * lg);
        uint2 kv[15];
#pragma unroll
        for (int n = 0; n < 15; ++n) kv[n] = *(const uint2*)(KV + (size_t)((b * 16 + n) * 4 + h) * 16384 + off);
        float4 st = make_float4(0.f, 0.f, 0.f, 0.f);
#pragma unroll
        for (int n = 0; n < 16; ++n) {
            *(uint2*)(ST + (size_t)((b * 16 + n) * 4 + h) * 16384 + off) = pack4(st.x, st.y, st.z, st.w);
            if (n < 15) {
                st.x = st.x * cd + bf2f((u16)(kv[n].x & 0xffff)); st.y = st.y * cd + bf2f((u16)(kv[n].x >> 16));
                st.z = st.z * cd + bf2f((u16)(kv[n].y & 0xffff)); st.w = st.w * cd + bf2f((u16)(kv[n].y >> 16));
            }
        }
    }
}

DEVFN void phase45(const P& p, char* smem, int bid, int nb) {
    for (int chunk = bid; chunk < 256; chunk += nb) {
        int tid_ = threadIdx.x; asm volatile("" : "+v"(tid_));
        const int tid = tid_ & 511, lane = tid & 63, w = __builtin_amdgcn_readfirstlane(tid >> 6), fr = lane & 15, fq = lane >> 4;
        const int b = chunk >> 4, odd = fr & 1;
        u16* Yg = (u16*)(p.ws + OFF_Y) + (size_t)chunk * 128 * 1024;
        {
            char* igs = smem + 32768 + w * 13056;
            char* sgs = igs + 4352;
            char* ys = igs + 8704;
            const unsigned so = (unsigned)((tid >> 4) * 256 + (tid & 15) * 16);
            const unsigned wo = (unsigned)((w * 16 + (lane >> 4)) * 256 + (lane & 15) * 16);
            const unsigned qo = (unsigned)((w * 16 + fr) * 256 + fq * 16);
            uint4 stR0, stR1, stR2, stR3, igR0, igR1, igR2, igR3, sgR0, sgR1, sgR2, sgR3;
            bf16x8 qa0, qa1, qa2, qa3;
#define P4_LOADS(HB) { \
                const char* stg = p.ws + OFF_ST + (HB); const char* igg = p.ws + OFF_INTRA + (HB); const char* sgg = p.ws + OFF_SG + (HB); const char* qdg = p.ws + OFF_QD + (HB); \
                stR0 = *(const uint4*)(stg + so); stR1 = *(const uint4*)(stg + (so + 8192u)); stR2 = *(const uint4*)(stg + (so + 16384u)); stR3 = *(const uint4*)(stg + (so + 24576u)); \
                igR0 = *(const uint4*)(igg + wo); igR1 = *(const uint4*)(igg + (wo + 1024u)); igR2 = *(const uint4*)(igg + (wo + 2048u)); igR3 = *(const uint4*)(igg + (wo + 3072u)); \
                sgR0 = *(const uint4*)(sgg + wo); sgR1 = *(const uint4*)(sgg + (wo + 1024u)); sgR2 = *(const uint4*)(sgg + (wo + 2048u)); sgR3 = *(const uint4*)(sgg + (wo + 3072u)); \
                qa0 = *(const bf16x8*)(qdg + qo); qa1 = *(const bf16x8*)(qdg + (qo + 64u)); qa2 = *(const bf16x8*)(qdg + (qo + 128u)); qa3 = *(const bf16x8*)(qdg + (qo + 192u)); }
            P4_LOADS((size_t)(chunk * 4) * 32768)
#pragma unroll
            for (int hh = 0; hh < 4; ++hh) {
                {
                    const int sr = tid >> 4, sc = tid & 15, wr = lane >> 4, wc = (lane & 15) * 16;
                    *(uint4*)(smem + swz(sr, sc)) = stR0; *(uint4*)(smem + swz(sr + 32, sc)) = stR1;
                    *(uint4*)(smem + swz(sr + 64, sc)) = stR2; *(uint4*)(smem + swz(sr + 96, sc)) = stR3;
                    *(uint4*)(igs + wr * 272 + wc) = igR0; *(uint4*)(igs + (wr + 4) * 272 + wc) = igR1;
                    *(uint4*)(igs + (wr + 8) * 272 + wc) = igR2; *(uint4*)(igs + (wr + 12) * 272 + wc) = igR3;
                    *(uint4*)(sgs + wr * 272 + wc) = sgR0; *(uint4*)(sgs + (wr + 4) * 272 + wc) = sgR1;
                    *(uint4*)(sgs + (wr + 8) * 272 + wc) = sgR2; *(uint4*)(sgs + (wr + 12) * 272 + wc) = sgR3;
                }
                lds_barrier();
                bf16x8 qc[4];
                qc[0] = qa0; qc[1] = qa1; qc[2] = qa2; qc[3] = qa3;
                P4_LOADS((size_t)(chunk * 4 + (hh < 3 ? hh + 1 : 3)) * 32768)
                f32x4 o[8];
#pragma unroll
                for (int nt = 0; nt < 8; ++nt) {
                    o[nt] = (f32x4){0.f, 0.f, 0.f, 0.f};
#pragma unroll
                    for (int ks = 0; ks < 4; ++ks) o[nt] = mfma16(qc[ks], frag(smem, nt, ks, fr, fq), o[nt]);
                }
#pragma unroll
                for (int nt = 0; nt < 8; ++nt)
#pragma unroll
                    for (int r = 0; r < 4; ++r) o[nt][r] += bf2f(*(const u16*)(igs + (fq * 4 + r) * 272 + (nt * 16 + fr) * 2));
                float gng[8];
#pragma unroll
                for (int nt = 0; nt < 8; ++nt) gng[nt] = p.gn_g[hh * 128 + nt * 16 + fr];
#pragma unroll
                for (int rp = 0; rp < 2; ++rp) {
                    float yv[2][8];
#pragma unroll
                    for (int r2 = 0; r2 < 2; ++r2) {
                        const int r = rp * 2 + r2;
                        float s = 0.f;
#pragma unroll
                        for (int nt = 0; nt < 8; ++nt) s += o[nt][r];
                        s = red16(s);
                        const float mean = s * (1.0f / 128.0f);
                        float q2 = 0.f;
#pragma unroll
                        for (int nt = 0; nt < 8; ++nt) { const float dv = o[nt][r] - mean; q2 += dv * dv; }
                        q2 = red16(q2);
                        const float rstd = rsqrtf(q2 * (1.0f / 128.0f) + 1e-6f);
#pragma unroll
                        for (int nt = 0; nt < 8; ++nt) {
                            const float gv = bf2f(*(const u16*)(sgs + (fq * 4 + r) * 272 + (nt * 16 + fr) * 2));
                            yv[r2][nt] = (o[nt][r] - mean) * rstd * gng[nt] * gv;
                        }
                    }
#pragma unroll
                    for (int nt = 0; nt < 8; ++nt)
                        *(uint32_t*)(ys + (fq * 4 + rp * 2 + odd) * 272 + (nt * 16 + (fr & ~1)) * 2) = pair_pack(yv[0][nt], yv[1][nt], odd);
                }
                asm volatile("s_waitcnt lgkmcnt(0)" ::: "memory");
                char* yo = (char*)(Yg + (size_t)(w * 16) * 1024 + 512 + hh * 128);
#pragma unroll
                for (int i = 0; i < 4; ++i) {
                    const int row = (lane >> 4) + 4 * i, ch = lane & 15;
                    *(uint4*)(yo + (unsigned)(row * 2048 + ch * 16)) = *(const uint4*)(ys + row * 272 + ch * 16);
                }
                lds_barrier();
            }
        }
        __threadfence_block();
        __syncthreads();
        float* part = (float*)(smem + SM_SMALL);
        float* rsv = (float*)(smem + 65536);
        f32x4 acc[8][4];
        char* outb = (char*)(p.out + (size_t)chunk * 128 * 1024 + w * 64);
        const char* xb = (const char*)(p.x + (size_t)chunk * 128 * 1024 + w * 64);
        const unsigned oo = (unsigned)(fq * 16384 + fr * 4);
        u16* Zg = (u16*)(p.ws + OFF_Z) + (size_t)chunk * 128 * 512;
#define ROWSQ(HF) \
        _Pragma("unroll") for (int mt = 0; mt < 8; ++mt) \
        _Pragma("unroll") for (int r = 0; r < 4; ++r) { \
            float s = 0.f; \
            _Pragma("unroll") for (int nt = 0; nt < 4; ++nt) s += acc[mt][nt][r] * acc[mt][nt][r]; \
            s = red16(s); \
            if (fr == 0) part[((HF) * 8 + w) * 128 + mt * 16 + fq * 4 + r] = s; \
        }
        {
            const bf16x8* Bf = (const bf16x8*)(p.ws + OFF_WOUTF) + ((size_t)(0 * 8 + w) * 128) * 64;
            gemm_core<4>(Yg, Bf, smem, acc);
            ROWSQ(0)
            char* zb = (char*)(Zg + w * 64);
            const unsigned zo = (unsigned)((fq * 4 + odd) * 1024 + (fr & ~1) * 2);
#pragma unroll
            for (int mt = 0; mt < 8; ++mt) {
                char* zm = zb + mt * 16384;
#pragma unroll
                for (int nt = 0; nt < 4; ++nt)
#pragma unroll
                    for (int rp = 0; rp < 2; ++rp)
                        *(uint32_t*)(zm + (zo + (unsigned)(rp * 2048 + nt * 32))) = pair_pack(acc[mt][nt][rp * 2], acc[mt][nt][rp * 2 + 1], odd);
            }
        }
        {
            const bf16x8* Bf = (const bf16x8*)(p.ws + OFF_WOUTF) + ((size_t)(1 * 8 + w) * 128) * 64;
            gemm_core<4>(Yg, Bf, smem, acc);
            ROWSQ(1)
        }
        __syncthreads();
        if (tid < 128) {
            float s = 0.f;
#pragma unroll
            for (int k = 0; k < 16; ++k) s += part[k * 128 + tid];
            rsv[tid] = rsqrtf(s * (1.0f / 1024.0f) + 1e-6f);
        }
        lds_barrier();
        const float* gate = (const float*)(p.ws + OFF_MOD) + b * 3072 + 2048;
        {
            float gg[4];
#pragma unroll
            for (int nt = 0; nt < 4; ++nt) { const int col = 512 + w * 64 + nt * 16 + fr; gg[nt] = gate[col] * p.g_post[col]; }
#pragma unroll
            for (int mt = 0; mt < 8; ++mt)
#pragma unroll
                for (int r = 0; r < 4; ++r) {
                    const float rs = rsv[mt * 16 + fq * 4 + r];
                    char* ob = outb + (mt * 16 + r) * 4096 + 2048;
                    const char* xr = xb + (mt * 16 + r) * 4096 + 2048;
#pragma unroll
                    for (int nt = 0; nt < 4; ++nt)
                        *(float*)(ob + (oo + (unsigned)(nt * 64))) = *(const float*)(xr + (oo + (unsigned)(nt * 64))) + gg[nt] * acc[mt][nt][r] * rs;
                }
        }
        {
            const int c8 = (tid & 63) * 8, r0 = tid >> 6;
            float gq[8];
            {
                const float4 g0 = *(const float4*)(gate + c8), g1 = *(const float4*)(gate + c8 + 4);
                const float4 p0 = *(const float4*)(p.g_post + c8), p1 = *(const float4*)(p.g_post + c8 + 4);
                gq[0] = g0.x * p0.x; gq[1] = g0.y * p0.y; gq[2] = g0.z * p0.z; gq[3] = g0.w * p0.w;
                gq[4] = g1.x * p1.x; gq[5] = g1.y * p1.y; gq[6] = g1.z * p1.z; gq[7] = g1.w * p1.w;
            }
            char* ob = (char*)(p.out + (size_t)chunk * 128 * 1024);
            const char* xr = (const char*)(p.x + (size_t)chunk * 128 * 1024);
            const char* zr = (const char*)Zg;
            const unsigned vo = (unsigned)(r0 * 4096 + c8 * 4), vz = (unsigned)(r0 * 1024 + c8 * 2);
#pragma unroll 4
            for (int i = 0; i < 16; ++i) {
                const uint4 z = *(const uint4*)(zr + (vz + (unsigned)(i * 8192)));
                const float4 x0 = *(const float4*)(xr + (vo + (unsigned)(i * 32768)));
                const float4 x1 = *(const float4*)(xr + (vo + (unsigned)(i * 32768 + 16)));
                const float rs = rsv[i * 8 + r0];
                float4 o0, o1;
                o0.x = x0.x + gq[0] * bf2f((u16)(z.x & 0xffff)) * rs; o0.y = x0.y + gq[1] * bf2f((u16)(z.x >> 16)) * rs;
                o0.z = x0.z + gq[2] * bf2f((u16)(z.y & 0xffff)) * rs; o0.w = x0.w + gq[3] * bf2f((u16)(z.y >> 16)) * rs;
                o1.x = x1.x + gq[4] * bf2f((u16)(z.z & 0xffff)) * rs; o1.y = x1.y + gq[5] * bf2f((u16)(z.z >> 16)) * rs;
                o1.z = x1.z + gq[6] * bf2f((u16)(z.w & 0xffff)) * rs; o1.w = x1.w + gq[7] * bf2f((u16)(z.w >> 16)) * rs;
                *(float4*)(ob + (vo + (unsigned)(i * 32768))) = o0;
                *(float4*)(ob + (vo + (unsigned)(i * 32768 + 16))) = o1;
            }
        }
        lds_barrier();
    }
}

#ifndef N_LAUNCHES
#define N_LAUNCHES 1
#endif

#if N_LAUNCHES == 1
__global__ void __launch_bounds__(NTHREADS) fwd(P p) {
    __shared__ __attribute__((aligned(16))) char smem[SM_TOTAL];
    const int bid = blockIdx.x, nb = gridDim.x;
    if (threadIdx.x == 0) *(uint4*)(smem + SM_BARW) = make_uint4(0u, 0u, 0u, 0u);
    __syncthreads();
    XcdBarrier xb = xcd_barrier_post((unsigned*)(p.ws + OFF_BAR), (volatile LAS unsigned*)(smem + SM_BARW));
#ifndef REP0
#define REP0 1
#define REP1 1
#define REP2 1
#define REP3 1
#define REP4 1
#endif
#pragma unroll 1
    for (int i = 0; i < REP0; ++i) phase0(p, smem, bid, nb);
    xcd_barrier(xb);
#pragma unroll 1
    for (int i = 0; i < REP1; ++i) phase1(p, bid, nb);
    xcd_barrier(xb);
#pragma unroll 1
    for (int i = 0; i < REP2; ++i) phase2(p, smem, bid, nb);
    xcd_barrier(xb);
#pragma unroll 1
    for (int i = 0; i < REP3; ++i) phase3(p, bid, nb);
    xcd_barrier(xb);
#pragma unroll 1
    for (int i = 0; i < REP4; ++i) phase45(p, smem, bid, nb);
}
#else
__global__ void __launch_bounds__(NTHREADS) k_phase0(P p) { __shared__ __attribute__((aligned(16))) char smem[SM_TOTAL]; phase0(p, smem, blockIdx.x, gridDim.x); }
__global__ void __launch_bounds__(NTHREADS) k_phase1(P p) { phase1(p, blockIdx.x, gridDim.x); }
__global__ void __launch_bounds__(NTHREADS) k_phase2(P p) { __shared__ __attribute__((aligned(16))) char smem[SM_TOTAL]; phase2(p, smem, blockIdx.x, gridDim.x); }
__global__ void __launch_bounds__(NTHREADS) k_phase3(P p) { phase3(p, blockIdx.x, gridDim.x); }
__global__ void __launch_bounds__(NTHREADS) k_phase45(P p) { __shared__ __attribute__((aligned(16))) char smem[SM_TOTAL]; phase45(p, smem, blockIdx.x, gridDim.x); }
#endif

extern "C" void kernel_launch(void* const* d_in, const int* in_sizes, int n_in, void* d_out, int out_size, void* d_ws, size_t ws_size,
                              hipStream_t stream) {
    P p{};
    p.x = (const float*)d_in[0]; p.c = (const float*)d_in[1]; p.pos = (const int*)d_in[2]; p.w_ada = (const float*)d_in[3];
    p.b_ada = (const float*)d_in[4]; p.g_pre = (const float*)d_in[5]; p.w_in = (const float*)d_in[6]; p.ln_g = (const float*)d_in[7];
    p.gws = (const float*)d_in[8]; p.gbs = (const float*)d_in[9]; p.gn_g = (const float*)d_in[10]; p.w_out = (const float*)d_in[11];
    p.g_post = (const float*)d_in[12]; p.out = (float*)d_out; p.ws = (char*)d_ws;
    p.ph_lo = 0; p.ph_hi = 5;
    const int grid = 256;
#if N_LAUNCHES == 1
    (void)hipMemsetAsync((char*)d_ws + OFF_BAR, 0, OFF_MOD + 16 * 3072 * 4, stream);
    void* args[] = {&p};
    hipError_t e = hipLaunchCooperativeKernel((const void*)fwd, dim3(grid), dim3(NTHREADS), args, 0, stream);
    if (e != hipSuccess) fprintf(stderr, "cooperative launch failed: %s\n", hipGetErrorString(e));
#else
    hipLaunchKernelGGL(k_phase0, dim3(grid), dim3(NTHREADS), 0, stream, p);
    hipLaunchKernelGGL(k_phase1, dim3(grid), dim3(NTHREADS), 0, stream, p);
    hipLaunchKernelGGL(k_phase2, dim3(grid), dim3(NTHREADS), 0, stream, p);
    hipLaunchKernelGGL(k_phase3, dim3(grid), dim3(NTHREADS), 0, stream, p);
    hipLaunchKernelGGL(k_phase45, dim3(grid), dim3(NTHREADS), 0, stream, p);
#endif
}
```

```cpp
#include <hip/hip_runtime.h>
#include <stdint.h>
#include <stdio.h>

typedef __attribute__((ext_vector_type(8))) short bf16x8;
typedef __attribute__((ext_vector_type(4))) float f32x4;
typedef unsigned short u16;
#define DEVFN __device__ __forceinline__
#define NTHREADS 512
#define LAS __attribute__((address_space(3)))

#define OFF_BAR    0ull
#define OFF_MOD    16384ull
#define OFF_WINF   262144ull
#define OFF_WOUTF  7602176ull
#define OFF_WS     9699328ull
#define OFF_H      16777216ull
#define OFF_Y      83886080ull
#define OFF_QD     150994944ull
#define OFF_SG     184549376ull
#define OFF_INTRA  218103808ull
#define OFF_KV     285212672ull
#define OFF_ST     OFF_H
#define OFF_TAB    385875968ull
#define OFF_Z      (OFF_H + 33554432ull)

#define SM_SMALL   139264
#define SM_BARW    147456
#define SM_TOTAL   (147456 + 16)

struct P {
    const float* x; const float* c; const int* pos; const float* w_ada; const float* b_ada; const float* g_pre;
    const float* w_in; const float* ln_g; const float* gws; const float* gbs; const float* gn_g; const float* w_out;
    const float* g_post; float* out; char* ws;
    int ph_lo, ph_hi;
};

typedef __attribute__((ext_vector_type(2))) __bf16 bf2_t;
DEVFN u16 f2bf(float f) { return __builtin_bit_cast(u16, (__bf16)f); }
DEVFN float bf2f(u16 h) { return __uint_as_float(((uint32_t)h) << 16); }
DEVFN uint32_t pack2(float a, float b) { bf2_t v = {(__bf16)a, (__bf16)b}; return __builtin_bit_cast(uint32_t, v); }
DEVFN void lds_barrier() { asm volatile("s_waitcnt lgkmcnt(0)\n\ts_barrier" ::: "memory"); }
DEVFN uint2 pack4(float a, float b, float c, float d) { uint2 r; r.x = pack2(a, b); r.y = pack2(c, d); return r; }
DEVFN float silu(float x) { return x * __builtin_amdgcn_rcpf(1.0f + __expf(-x)); }
template <int CTRL> DEVFN float dppf(float v) { return __int_as_float(__builtin_amdgcn_update_dpp(0, __float_as_int(v), CTRL, 0xF, 0xF, true)); }
DEVFN float red16(float v) { v += dppf<0x128>(v); v += dppf<0x124>(v); v += dppf<0x4E>(v); v += dppf<0xB1>(v); return v; }
DEVFN float red4(float v) { v += dppf<0x4E>(v); v += dppf<0xB1>(v); return v; }
DEVFN float swap1(float v) { return __int_as_float(__builtin_amdgcn_update_dpp(0, __float_as_int(v), 0xB1, 0xF, 0xF, true)); }
DEVFN uint32_t pair_pack(float a, float b, int odd) {
    const float recv = swap1(odd ? a : b);
    return odd ? pack2(recv, b) : pack2(a, recv);
}
DEVFN int swz(int row, int chunk) { return row * 256 + ((chunk ^ (row & 15)) << 4); }
DEVFN bf16x8 frag(const char* base, int tile, int ks, int fr, int fq) {
    return *(const bf16x8*)(base + swz(tile * 16 + fr, ks * 4 + fq));
}
DEVFN f32x4 mfma16(bf16x8 a, bf16x8 b, f32x4 c) { return __builtin_amdgcn_mfma_f32_16x16x32_bf16(a, b, c, 0, 0, 0); }

#define XB_TMO      128
#define XB_XCNT(j)  (256  + 64 * (j))
#define XB_XSUB(j)  (1280 + 64 * (j))
#define XB_XGEN(j)  (2304 + 64 * (j))
#define XB_TOP      3328
#define XB_TOPGEN   3392
#define XCD_BAR_WORDS 3456
#define XB_SPIN_CAP (1u << 22)
DEVFN unsigned xb_ld(unsigned* p) { return __hip_atomic_load(p, __ATOMIC_RELAXED, __HIP_MEMORY_SCOPE_AGENT); }
DEVFN unsigned xb_add(unsigned* p, unsigned v) { return __hip_atomic_fetch_add(p, v, __ATOMIC_RELAXED, __HIP_MEMORY_SCOPE_AGENT); }
DEVFN unsigned xb_xcc_id() { return (unsigned)__builtin_amdgcn_s_getreg((3 << 11) | 20) & 0xFu; }
#define XB_SPIN(cond, bar) do { unsigned _sp = 0; while (cond) { __builtin_amdgcn_s_sleep(1); \
    if ((++_sp & 255u) == 0u) { if (xb_ld(&(bar)[XB_TMO])) break; if (_sp > XB_SPIN_CAP) { atomicAdd(&(bar)[XB_TMO], 1u); break; } } } } while (0)
struct XcdBarrier { unsigned* bar; unsigned x; volatile LAS unsigned* st; };
DEVFN XcdBarrier xcd_barrier_post(unsigned* bar, volatile LAS unsigned* st) {
    XcdBarrier b; b.bar = bar; b.x = xb_xcc_id(); b.st = st;
    if (threadIdx.x == 0) (void)xb_add(&bar[XB_XCNT(b.x)], 1u);
    return b;
}
DEVFN void xcd_barrier_complete(unsigned* bar, unsigned x, unsigned& nloc, unsigned& nx) {
    const unsigned G = gridDim.x * gridDim.y * gridDim.z;
    unsigned sum, cnt, mine, sp = 0u;
    for (;;) {
        sum = 0u; cnt = 0u; mine = 0u;
#pragma unroll
        for (unsigned j = 0; j < 16; ++j) { const unsigned c = xb_ld(&bar[XB_XCNT(j)]); sum += c; cnt += (c > 0u) ? 1u : 0u; mine = (j == x) ? c : mine; }
        if (sum == G) break;
        __builtin_amdgcn_s_sleep(1);
        if ((++sp & 255u) == 0u) { if (xb_ld(&bar[XB_TMO])) break; if (sp > XB_SPIN_CAP) { atomicAdd(&bar[XB_TMO], 1u); break; } }
    }
    nloc = mine > 0u ? mine : 1u; nx = cnt > 0u ? cnt : 1u;
}
DEVFN void xcd_barrier(const XcdBarrier& b) {
    asm volatile("s_waitcnt vmcnt(0)" ::: "memory");
    __syncthreads();
    if (threadIdx.x == 0) {
        unsigned* bar = b.bar;
        __builtin_amdgcn_s_waitcnt(0);
        unsigned nloc = b.st[0], nx = b.st[1];
        if (nloc == 0u) { xcd_barrier_complete(bar, b.x, nloc, nx); b.st[0] = nloc; b.st[1] = nx; }
        const unsigned old = xb_add(&bar[XB_XSUB(b.x)], 1u);
        const unsigned gen = old / nloc;
        if (old + 1u == (gen + 1u) * nloc) {
            __builtin_amdgcn_fence(__ATOMIC_RELEASE, "agent");
            asm volatile("s_waitcnt vmcnt(0)" ::: "memory");
            const unsigned og = xb_add(&bar[XB_TOP], 1u);
            const unsigned tg = og / nx;
            if (og + 1u == (tg + 1u) * nx) xb_add(&bar[XB_TOPGEN], 1u);
            else XB_SPIN(xb_ld(&bar[XB_TOPGEN]) == tg, bar);
            __builtin_amdgcn_fence(__ATOMIC_ACQUIRE, "agent");
            xb_add(&bar[XB_XGEN(b.x)], 1u);
            asm volatile("s_waitcnt vmcnt(0)" ::: "memory");
        } else {
            XB_SPIN(xb_ld(&bar[XB_XGEN(b.x)]) == gen, bar);
            __builtin_amdgcn_fence(__ATOMIC_ACQUIRE, "agent");
            asm volatile("s_waitcnt vmcnt(0)" ::: "memory");
        }
    }
    __syncthreads();
}

DEVFN int proj_feature(int j, int w, int nt, int c) {
    if (j < 4) return nt * 512 + j * 128 + w * 16 + c;
    const int hh = j - 4;
    if (nt < 2) return (c < 8 ? 1536 : 2048) + hh * 128 + nt * 64 + w * 8 + (c & 7);
    if (nt == 2) return 2560 + hh * 128 + w * 16 + c;
    return 3072 + hh * 128 + w * 16 + c;
}

DEVFN void phase0(const P& p, char* smem, int bid, int nb) {
    const int tid = threadIdx.x, lane = tid & 63, w = __builtin_amdgcn_readfirstlane(tid >> 6);
    const int N_MOD = 768, N_WIN = 896, N_WOUT = 256, N_WS = 16;
    const int NITEMS = N_MOD + N_WIN + N_WOUT + N_WS;
    for (int it = bid; it < NITEMS; it += nb) {
        if (it < N_MOD) {
            float* sc = (float*)smem;
            float* red = (float*)(smem + 65536);
            const int cg = it >> 3, ksp = it & 7, e0 = cg * 32, d0 = ksp * 128;
            lds_barrier();
            for (int i = tid; i < 2048; i += NTHREADS) sc[i] = silu(p.c[(i >> 7) * 1024 + d0 + (i & 127)]);
            lds_barrier();
            const int col = tid & 31, kg = tid >> 5;
            float wv[8];
#pragma unroll
            for (int q = 0; q < 8; ++q) wv[q] = p.w_ada[(size_t)(d0 + kg * 8 + q) * 3072 + e0 + col];
            float acc[16];
#pragma unroll
            for (int b = 0; b < 16; ++b) {
                float a = 0.f;
#pragma unroll
                for (int q = 0; q < 8; ++q) a += sc[b * 128 + kg * 8 + q] * wv[q];
                acc[b] = a;
            }
#pragma unroll
            for (int b = 0; b < 16; ++b) red[(kg * 16 + b) * 32 + col] = acc[b];
            lds_barrier();
            {
                const int b = tid >> 5;
                float s = (ksp == 0) ? p.b_ada[e0 + col] : 0.f;
#pragma unroll
                for (int k = 0; k < 16; ++k) s += red[(k * 16 + b) * 32 + col];
                atomicAdd((float*)(p.ws + OFF_MOD) + b * 3072 + e0 + col, s);
            }
        } else if (it < N_MOD + N_WIN) {
            const int F = (it - N_MOD) * 8 + w;
            int j, ww, ks, nt;
            if (F < 3072) { j = F / 768; int rem = F % 768; ww = rem / 96; int r2 = rem % 96; ks = r2 / 3; nt = r2 % 3; }
            else { int f2 = F - 3072; j = 4 + f2 / 1024; int rem = f2 % 1024; ww = rem / 128; int r2 = rem % 128; ks = r2 / 4; nt = r2 % 4; }
            const int f = proj_feature(j, ww, nt, lane & 15);
            const int k0 = ks * 32 + (lane >> 4) * 8;
            float v[8];
#pragma unroll
            for (int q = 0; q < 8; ++q) v[q] = p.w_in[(size_t)(k0 + q) * 3584 + f];
            uint4 o; o.x = pack2(v[0], v[1]); o.y = pack2(v[2], v[3]); o.z = pack2(v[4], v[5]); o.w = pack2(v[6], v[7]);
            ((uint4*)(p.ws + OFF_WINF))[(size_t)F * 64 + lane] = o;
        } else if (it < N_MOD + N_WIN + N_WOUT) {
            const int F = (it - N_MOD - N_WIN) * 8 + w;
            const int nt = F & 3, ks = (F >> 2) & 31, hw = F >> 7;
            const int n = hw * 64 + nt * 16 + (lane & 15);
            const int k0 = ks * 32 + (lane >> 4) * 8;
            float v[8];
#pragma unroll
            for (int q = 0; q < 8; ++q) v[q] = p.w_out[(size_t)(k0 + q) * 1024 + n];
            uint4 o; o.x = pack2(v[0], v[1]); o.y = pack2(v[2], v[3]); o.z = pack2(v[4], v[5]); o.w = pack2(v[6], v[7]);
            ((uint4*)(p.ws + OFF_WOUTF))[(size_t)F * 64 + lane] = o;
        } else {
            const int base = (it - N_MOD - N_WIN - N_WOUT) * 4096 + tid * 8;
            const int t = (base >> 7) & 127, s0 = base & 127;
            float v[8];
#pragma unroll
            for (int q = 0; q < 8; ++q) v[q] = (s0 + q <= t) ? p.gws[base + q] : 0.f;
            uint4 o; o.x = pack2(v[0], v[1]); o.y = pack2(v[2], v[3]); o.z = pack2(v[4], v[5]); o.w = pack2(v[6], v[7]);
            *(uint4*)((u16*)(p.ws + OFF_WS) + base) = o;
        }
    }
}

DEVFN void phase1(const P& p, int bid, int nb) {
    const int tid = threadIdx.x, lane = tid & 63, w = __builtin_amdgcn_readfirstlane(tid >> 6);
    const float* mod = (const float*)(p.ws + OFF_MOD);
    u16* H = (u16*)(p.ws + OFF_H);
    for (int rg = bid * 8 + w; rg < 2048; rg += nb * 8) {
        const int b = rg >> 7;

        float gs[16], sh[16];
#pragma unroll
        for (int i = 0; i < 4; ++i) {
            const int col = (i * 64 + lane) * 4;
            const float4 g = *(const float4*)(p.g_pre + col);
            const float4 s = *(const float4*)(mod + b * 3072 + 1024 + col);
            const float4 t = *(const float4*)(mod + b * 3072 + col);
            gs[i * 4 + 0] = g.x * (1.f + s.x); gs[i * 4 + 1] = g.y * (1.f + s.y); gs[i * 4 + 2] = g.z * (1.f + s.z); gs[i * 4 + 3] = g.w * (1.f + s.w);
            sh[i * 4 + 0] = t.x; sh[i * 4 + 1] = t.y; sh[i * 4 + 2] = t.z; sh[i * 4 + 3] = t.w;
        }
#pragma unroll 4
        for (int r = 0; r < 16; ++r) {
            const size_t row = (size_t)rg * 16 + r;
            const float4* xr = (const float4*)(p.x + row * 1024);
            float4 v[4];
#pragma unroll
            for (int i = 0; i < 4; ++i) v[i] = xr[i * 64 + lane];
            float ss = 0.f;
#pragma unroll
            for (int i = 0; i < 4; ++i) ss += v[i].x * v[i].x + v[i].y * v[i].y + v[i].z * v[i].z + v[i].w * v[i].w;
            ss = red16(ss); ss += __shfl_xor(ss, 16); ss += __shfl_xor(ss, 32);
            const float rs = rsqrtf(ss * (1.0f / 1024.0f) + 1e-6f);
#pragma unroll
            for (int i = 0; i < 4; ++i) {
                const uint2 o = pack4(v[i].x * rs * gs[i * 4 + 0] + sh[i * 4 + 0], v[i].y * rs * gs[i * 4 + 1] + sh[i * 4 + 1],
                                      v[i].z * rs * gs[i * 4 + 2] + sh[i * 4 + 2], v[i].w * rs * gs[i * 4 + 3] + sh[i * 4 + 3]);
                *(uint2*)(H + row * 1024 + (i * 64 + lane) * 4) = o;
            }
        }
    }
}

template <int NT>
DEVFN void gemm_step(const char* An, const char* Bn, const unsigned avo, const unsigned bvo, char* smem, const int cur, const int aw,
                     const int foff0, const int foff1, f32x4 (&acc)[8][NT], const bf16x8 (&bc)[2][NT], bf16x8 (&bn)[2][NT],
                     const uint4& w0, const uint4& w1, uint4& l0, uint4& l1) {
    l0 = *(const uint4*)(An + avo); l1 = *(const uint4*)(An + (avo + 131072u));
#pragma unroll
    for (int ss = 0; ss < 2; ++ss)
#pragma unroll
        for (int nt = 0; nt < NT; ++nt) bn[ss][nt] = *(const bf16x8*)(Bn + (bvo + (unsigned)((ss * NT + nt) * 1024)));
    __builtin_amdgcn_sched_barrier(0);
    {
        bf16x8 x0 = *(const bf16x8*)(smem + cur + foff0), x1 = *(const bf16x8*)(smem + cur + 2048 + foff0);
#pragma unroll
        for (int g = 0; g < 8; ++g) {
            const int ss = g >> 2, m0 = (g & 3) * 2;
            bf16x8 y0 = x0, y1 = x1;
            if (g < 7) {
                const int gn = g + 1, fo = (gn >> 2) ? foff1 : foff0, mn = (gn & 3) * 2;
                y0 = *(const bf16x8*)(smem + cur + mn * 2048 + fo);
                y1 = *(const bf16x8*)(smem + cur + (mn + 1) * 2048 + fo);
            }
            __builtin_amdgcn_sched_barrier(0);
#pragma unroll
            for (int nt = 0; nt < NT; ++nt) {
                acc[m0][nt] = mfma16(x0, bc[ss][nt], acc[m0][nt]);
                acc[m0 + 1][nt] = mfma16(x1, bc[ss][nt], acc[m0 + 1][nt]);
            }
            x0 = y0; x1 = y1;
        }
    }
    __builtin_amdgcn_sched_barrier(0);
    *(uint4*)(smem + (cur ^ 16384) + aw) = w0;
    *(uint4*)(smem + (cur ^ 16384) + aw + 8192) = w1;
    lds_barrier();
}

template <int NT, bool PF = false>
DEVFN void gemm_core(const u16* __restrict__ A, const bf16x8* __restrict__ Bf, char* smem, f32x4 (&acc)[8][NT], const char* pf = nullptr) {
    int tid_ = threadIdx.x; asm volatile("" : "+v"(tid_));
    const int tid = tid_ & 511, lane = tid & 63;
    const int fr = lane & 15, fq = lane >> 4;
    const int ar = tid >> 3, ac = tid & 7;
    const char* Ab = (const char*)A;
    const char* Bb = (const char*)Bf;
    const unsigned avo = (unsigned)(ar * 2048 + ac * 16);
    const unsigned bvo = (unsigned)(lane * 16);
    const int aw = ar * 128 + ((ac ^ (ar & 7)) << 4);
    const int foff0 = fr * 128 + (((0 + fq) ^ (fr & 7)) << 4);
    const int foff1 = fr * 128 + (((4 + fq) ^ (fr & 7)) << 4);
#pragma unroll
    for (int mt = 0; mt < 8; ++mt)
#pragma unroll
        for (int nt = 0; nt < NT; ++nt) acc[mt][nt] = (f32x4){0.f, 0.f, 0.f, 0.f};
    uint4 ra0, ra1, rb0, rb1;
    {
        const uint4 a0 = *(const uint4*)(Ab + avo), a1 = *(const uint4*)(Ab + (avo + 131072u));
        rb0 = *(const uint4*)(Ab + 128 + avo); rb1 = *(const uint4*)(Ab + 128 + (avo + 131072u));
        *(uint4*)(smem + aw) = a0;
        *(uint4*)(smem + aw + 8192) = a1;
    }
    bf16x8 b0[2][NT], b1[2][NT];
#pragma unroll
    for (int ss = 0; ss < 2; ++ss)
#pragma unroll
        for (int nt = 0; nt < NT; ++nt) b0[ss][nt] = *(const bf16x8*)(Bb + (bvo + (unsigned)((ss * NT + nt) * 1024)));
    lds_barrier();
    const unsigned pfo = (unsigned)(((tid >> 6) * 64 + lane) * 64);
    float pfv = 0.f;
#pragma unroll 1
    for (int k2 = 0; k2 < 8; ++k2) {
        if (PF) {
            asm volatile("" :: "v"(pfv));
            const float t0 = *(const float*)(pf + (pfo + (unsigned)(k2 * 65536)));
            const float t1 = *(const float*)(pf + (pfo + (unsigned)(k2 * 65536 + 32768)));
            pfv = t0 + t1;
        }
        const int n1 = 2 * k2 + 1;
        const int n2 = k2 < 7 ? 2 * k2 + 2 : 15;
        const int n3 = k2 < 7 ? 2 * k2 + 3 : 15;
        gemm_step<NT>(Ab + n2 * 128, Bb + n1 * (2 * NT * 1024), avo, bvo, smem, 0, aw, foff0, foff1, acc, b0, b1, rb0, rb1, ra0, ra1);
        gemm_step<NT>(Ab + n3 * 128, Bb + n2 * (2 * NT * 1024), avo, bvo, smem, 16384, aw, foff0, foff1, acc, b1, b0, ra0, ra1, rb0, rb1);
    }
    if (PF) asm volatile("" :: "v"(pfv));
}

#define G_VS   0
#define G_VLT  69632
#define G_WS   102400
#define G_Y    0
DEVFN void item_gmlp(const P& p, char* smem, int chunk, int g) {
    int tid_ = threadIdx.x; asm volatile("" : "+v"(tid_)); const int tid = tid_ & 511, lane = tid & 63, w = __builtin_amdgcn_readfirstlane(tid >> 6), fr = lane & 15, fq = lane >> 4;
    float* stats = (float*)(smem + SM_SMALL);
    float* bsv = (float*)(smem + SM_SMALL + 1024);
    if (tid < 128) bsv[tid] = p.gbs[g * 128 + tid];
    f32x4 acc[8][3];
    const u16* A = (const u16*)(p.ws + OFF_H) + (size_t)chunk * 128 * 1024;
    const bf16x8* Bf = (const bf16x8*)(p.ws + OFF_WINF) + ((size_t)g * 768 + w * 96) * 64;
    gemm_core<3>(A, Bf, smem, acc);
    const int d = w * 16 + fr;
    {
        float* VS = (float*)(smem + G_VS);
#pragma unroll
        for (int mt = 0; mt < 8; ++mt)
#pragma unroll
            for (int r = 0; r < 4; ++r) VS[(mt * 16 + fq * 4 + r) * 132 + d] = acc[mt][1][r];
        const uint4* wsg = (const uint4*)((const u16*)(p.ws + OFF_WS) + g * 16384);
#pragma unroll
        for (int i = 0; i < 4; ++i) {
            const int row = (tid >> 4) + 32 * i, ch = tid & 15;
            *(uint4*)(smem + G_WS + swz(row, ch)) = wsg[row * 16 + ch];
        }
    }
    lds_barrier();
    {
        const float* VS = (const float*)(smem + G_VS);
        const int row = tid >> 2, q = tid & 3;
        float v[32];
#pragma unroll
        for (int i = 0; i < 8; ++i) {
            const float4 t4 = *(const float4*)(VS + row * 132 + q * 32 + i * 4);
            v[i * 4 + 0] = t4.x; v[i * 4 + 1] = t4.y; v[i * 4 + 2] = t4.z; v[i * 4 + 3] = t4.w;
        }
        float s = 0.f;
#pragma unroll
        for (int i = 0; i < 32; ++i) s += v[i];
        s = red4(s);
        const float mean = s * (1.0f / 128.0f);
        float q2 = 0.f;
#pragma unroll
        for (int i = 0; i < 32; ++i) { const float dv = v[i] - mean; q2 += dv * dv; }
        q2 = red4(q2);
        if (q == 0) { stats[row * 2] = mean; stats[row * 2 + 1] = rsqrtf(q2 * (1.0f / 128.0f) + 1e-6f); }
    }
    lds_barrier();
    {
        const float lg = p.ln_g[g * 128 + d];
#pragma unroll
        for (int mt = 0; mt < 8; ++mt) {
            const int s0 = mt * 16 + fq * 4;
            float o[4];
#pragma unroll
            for (int r = 0; r < 4; ++r) {
                const float2 st = *(const float2*)(stats + (s0 + r) * 2);
                o[r] = (acc[mt][1][r] - st.x) * st.y * lg;
            }
            *(uint2*)(smem + G_VLT + swz(d, s0 >> 3) + (s0 & 7) * 2) = pack4(o[0], o[1], o[2], o[3]);
        }
    }
    lds_barrier();
    {
        bf16x8 bv[4];
#pragma unroll
        for (int ks = 0; ks < 4; ++ks) bv[ks] = frag(smem + G_VLT, w, ks, fr, fq);
#pragma unroll
        for (int mt = 0; mt < 8; ++mt) {
            f32x4 m = (f32x4){0.f, 0.f, 0.f, 0.f};
#pragma unroll
            for (int ks = 0; ks < 4; ++ks)
                if (ks * 32 <= mt * 16 + 15) m = mfma16(frag(smem + G_WS, mt, ks, fr, fq), bv[ks], m);
#pragma unroll
            for (int r = 0; r < 4; ++r) {
                const int t = mt * 16 + fq * 4 + r;
                const float o = acc[mt][0][r] * (m[r] + bsv[t]) * silu(acc[mt][2][r]);
                *(u16*)(smem + G_Y + t * 272 + d * 2) = f2bf(o);
            }
        }
    }
    lds_barrier();
    {
        u16* Y = (u16*)(p.ws + OFF_Y) + (size_t)chunk * 128 * 1024 + g * 128;
#pragma unroll
        for (int i = 0; i < 4; ++i) {
            const int row = (tid >> 4) + 32 * i, ch = tid & 15;
            *(uint4*)(Y + (size_t)row * 1024 + ch * 8) = *(const uint4*)(smem + G_Y + row * 272 + ch * 16);
        }
    }
    lds_barrier();
}

#define R_Q   0
#define R_K   32768
#define R_KT  65536
#define R_VT  98304
DEVFN void item_ret(const P& p, char* smem, int chunk, int hh) {
    int tid_ = threadIdx.x; asm volatile("" : "+v"(tid_)); const int tid = tid_ & 511, lane = tid & 63, w = __builtin_amdgcn_readfirstlane(tid >> 6), fr = lane & 15, fq = lane >> 4;
    float* posf = (float*)(smem + SM_SMALL);
    float* kdec = posf + 128;
    float* qdec = posf + 256;
    const float lg = __logf(1.0f - exp2f(-5.0f - (float)hh));
    if (tid < 128) {
        posf[tid] = (float)p.pos[chunk * 128 + tid];
        kdec[tid] = expf((float)(127 - tid) * lg);
        qdec[tid] = expf((float)(tid + 1) * lg);
    }
    f32x4 acc[8][4];
    const u16* A = (const u16*)(p.ws + OFF_H) + (size_t)chunk * 128 * 1024;
    const bf16x8* Bf = (const bf16x8*)(p.ws + OFF_WINF) + ((size_t)3072 + hh * 1024 + w * 128) * 64;
    gemm_core<4>(A, Bf, smem, acc);
    const size_t base = (size_t)(chunk * 4 + hh) * 16384;
    const int odd = fr & 1;
    {
        const int isk = fr >> 3, d = w * 8 + (fr & 7), de = d & ~1;
        const float scale = isk ? 0.08838834764831845f : 1.0f;
        const float invf = 1.0f / powf(10000.0f, (float)d * (1.0f / 64.0f));
        char* RX = smem + (isk ? R_K : R_Q);
        const int e = w * 16 + fr;
        char* sgb = (char*)((u16*)(p.ws + OFF_SG) + base + w * 16);
        const unsigned lo = (unsigned)((fq * 4 + odd) * 256 + (fr & ~1) * 2);
#pragma unroll
        for (int mt = 0; mt < 8; ++mt) {
            const int t0 = mt * 16 + fq * 4;
            float r1[4], r2[4];
#pragma unroll
            for (int r = 0; r < 4; ++r) {
                const float rev = (posf[t0 + r] * invf) * 0.15915494309189535f;
                const float frv = rev - floorf(rev);
                const float cs = __builtin_amdgcn_cosf(frv) * scale, sn = __builtin_amdgcn_sinf(frv) * scale;
                const float x1 = acc[mt][0][r], x2 = acc[mt][1][r];
                r1[r] = x1 * cs - x2 * sn; r2[r] = x2 * cs + x1 * sn;
            }
            if (isk) {
                const float4 kd = *(const float4*)(kdec + t0);
                *(uint2*)(smem + R_KT + swz(d, t0 >> 3) + (t0 & 7) * 2) = pack4(r1[0] * kd.x, r1[1] * kd.y, r1[2] * kd.z, r1[3] * kd.w);
                *(uint2*)(smem + R_KT + swz(d + 64, t0 >> 3) + (t0 & 7) * 2) = pack4(r2[0] * kd.x, r2[1] * kd.y, r2[2] * kd.z, r2[3] * kd.w);
            }
#pragma unroll
            for (int rp = 0; rp < 2; ++rp) {
                const int tr = t0 + rp * 2 + odd;
                *(uint32_t*)(RX + swz(tr, de >> 3) + (de & 7) * 2) = pair_pack(r1[rp * 2], r1[rp * 2 + 1], odd);
                *(uint32_t*)(RX + swz(tr, (de + 64) >> 3) + (de & 7) * 2) = pair_pack(r2[rp * 2], r2[rp * 2 + 1], odd);
            }
            *(uint2*)(smem + R_VT + swz(e, t0 >> 3) + (t0 & 7) * 2) = pack4(acc[mt][2][0], acc[mt][2][1], acc[mt][2][2], acc[mt][2][3]);
#pragma unroll
            for (int rp = 0; rp < 2; ++rp)
                *(uint32_t*)(sgb + (lo + (unsigned)(mt * 4096 + rp * 512))) = pair_pack(silu(acc[mt][3][rp * 2]), silu(acc[mt][3][rp * 2 + 1]), odd);
        }
    }
    lds_barrier();
    uint2 sreg[8];
    {
        u16* qd = (u16*)(p.ws + OFF_QD) + base;
#pragma unroll
        for (int i = 0; i < 4; ++i) {
            const int row = (tid >> 4) + 32 * i, ch = tid & 15;
            const uint4 v = *(const uint4*)(smem + R_Q + swz(row, ch));
            const float f = qdec[row];
            uint4 o;
            o.x = pack2(bf2f((u16)(v.x & 0xffff)) * f, bf2f((u16)(v.x >> 16)) * f);
            o.y = pack2(bf2f((u16)(v.y & 0xffff)) * f, bf2f((u16)(v.y >> 16)) * f);
            o.z = pack2(bf2f((u16)(v.z & 0xffff)) * f, bf2f((u16)(v.z >> 16)) * f);
            o.w = pack2(bf2f((u16)(v.w & 0xffff)) * f, bf2f((u16)(v.w >> 16)) * f);
            *(uint4*)(qd + row * 128 + ch * 8) = o;
        }
        f32x4 kv[8], sa[8];
#pragma unroll
        for (int nt = 0; nt < 8; ++nt) { kv[nt] = (f32x4){0.f, 0.f, 0.f, 0.f}; sa[nt] = (f32x4){0.f, 0.f, 0.f, 0.f}; }
#pragma unroll
        for (int ks = 0; ks < 4; ++ks) {
            const bf16x8 av = frag(smem + R_VT, w, ks, fr, fq);
            const bf16x8 ak = frag(smem + R_K, w, ks, fr, fq);
#pragma unroll
            for (int nt = 0; nt < 8; ++nt) {
                kv[nt] = mfma16(av, frag(smem + R_KT, nt, ks, fr, fq), kv[nt]);
                if (nt >= w) sa[nt] = mfma16(ak, frag(smem + R_Q, nt, ks, fr, fq), sa[nt]);
            }
        }
        char* kvb = (char*)((u16*)(p.ws + OFF_KV) + base + w * 2048);
        const unsigned lo = (unsigned)((fq * 4 + odd) * 256 + (fr & ~1) * 2);
#pragma unroll
        for (int nt = 0; nt < 8; ++nt)
#pragma unroll
            for (int rp = 0; rp < 2; ++rp)
                *(uint32_t*)(kvb + (lo + (unsigned)(rp * 512 + nt * 32))) = pair_pack(kv[nt][rp * 2], kv[nt][rp * 2 + 1], odd);
#pragma unroll
        for (int nt = 0; nt < 8; ++nt) {
            const int t = nt * 16 + fr, s0 = w * 16 + fq * 4;
            float o[4];
#pragma unroll
            for (int r = 0; r < 4; ++r) {
                const int s = s0 + r;
                o[r] = (t >= s) ? sa[nt][r] * __expf((float)(t - s) * lg) : 0.f;
            }
            sreg[nt] = pack4(o[0], o[1], o[2], o[3]);
        }
    }
    lds_barrier();
    {
        const int s0 = w * 16 + fq * 4;
#pragma unroll
        for (int nt = 0; nt < 8; ++nt) *(uint2*)(smem + R_KT + swz(nt * 16 + fr, s0 >> 3) + (s0 & 7) * 2) = sreg[nt];
    }
    lds_barrier();
    {
        f32x4 ia[8];
#pragma unroll
        for (int nt = 0; nt < 8; ++nt) ia[nt] = (f32x4){0.f, 0.f, 0.f, 0.f};
#pragma unroll
        for (int ks = 0; ks < 4; ++ks)
            if (ks * 32 <= w * 16 + 15) {
                const bf16x8 af = frag(smem + R_KT, w, ks, fr, fq);
#pragma unroll
                for (int nt = 0; nt < 8; ++nt) ia[nt] = mfma16(af, frag(smem + R_VT, nt, ks, fr, fq), ia[nt]);
            }
        char* igb = (char*)((u16*)(p.ws + OFF_INTRA) + base + w * 2048);
        const unsigned lo = (unsigned)((fq * 4 + odd) * 256 + (fr & ~1) * 2);
#pragma unroll
        for (int nt = 0; nt < 8; ++nt)
#pragma unroll
            for (int rp = 0; rp < 2; ++rp)
                *(uint32_t*)(igb + (lo + (unsigned)(rp * 512 + nt * 32))) = pair_pack(ia[nt][rp * 2], ia[nt][rp * 2 + 1], odd);
    }
    lds_barrier();
}

DEVFN void phase2(const P& p, char* smem, int bid, int nb) {
    for (int it = bid; it < 2048; it += nb) {
        const int chunk = it & 255, j = ((it >> 8) + ((chunk >> 3) & 1) * 4) & 7;
        if (j < 4) item_gmlp(p, smem, chunk, j);
        else item_ret(p, smem, chunk, j - 4);
    }
}

DEVFN void phase3(const P& p, int bid, int nb) {
    const u16* KV = (const u16*)(p.ws + OFF_KV);
    u16* ST = (u16*)(p.ws + OFF_ST);
    for (int i = bid * NTHREADS + threadIdx.x; i < 262144; i += nb * NTHREADS) {
        const int bh = i >> 12, b = bh >> 2, h = bh & 3, off = (i & 4095) * 4;
        const float lg = __logf(1.0f - exp2f(-5.0f - (float)h));
        const float cd = expf(128.0f * lg);
        uint2 kv[15];
#pragma unroll
        for (int n = 0; n < 15; ++n) kv[n] = *(const uint2*)(KV + (size_t)((b * 16 + n) * 4 + h) * 16384 + off);
        float4 st = make_float4(0.f, 0.f, 0.f, 0.f);
#pragma unroll
        for (int n = 0; n < 16; ++n) {
            *(uint2*)(ST + (size_t)((b * 16 + n) * 4 + h) * 16384 + off) = pack4(st.x, st.y, st.z, st.w);
            if (n < 15) {
                st.x = st.x * cd + bf2f((u16)(kv[n].x & 0xffff)); st.y = st.y * cd + bf2f((u16)(kv[n].x >> 16));
                st.z = st.z * cd + bf2f((u16)(kv[n].y & 0xffff)); st.w = st.w * cd + bf2f((u16)(kv[n].y >> 16));
            }
        }
    }
}

DEVFN void phase45(const P& p, char* smem, int bid, int nb) {
    for (int chunk = bid; chunk < 256; chunk += nb) {
        int tid_ = threadIdx.x; asm volatile("" : "+v"(tid_));
        const int tid = tid_ & 511, lane = tid & 63, w = __builtin_amdgcn_readfirstlane(tid >> 6), fr = lane & 15, fq = lane >> 4;
        const int b = chunk >> 4, odd = fr & 1;
        u16* Yg = (u16*)(p.ws + OFF_Y) + (size_t)chunk * 128 * 1024;
        {
            char* igs = smem + 32768 + w * 13056;
            char* sgs = igs + 4352;
            char* ys = igs + 8704;
            const unsigned so = (unsigned)((tid >> 4) * 256 + (tid & 15) * 16);
            const unsigned wo = (unsigned)((w * 16 + (lane >> 4)) * 256 + (lane & 15) * 16);
            const unsigned qo = (unsigned)((w * 16 + fr) * 256 + fq * 16);
            uint4 stR0, stR1, stR2, stR3, igR0, igR1, igR2, igR3, sgR0, sgR1, sgR2, sgR3;
            bf16x8 qa0, qa1, qa2, qa3;
#define P4_LOADS(HB) { \
                const char* stg = p.ws + OFF_ST + (HB); const char* igg = p.ws + OFF_INTRA + (HB); const char* sgg = p.ws + OFF_SG + (HB); const char* qdg = p.ws + OFF_QD + (HB); \
                stR0 = *(const uint4*)(stg + so); stR1 = *(const uint4*)(stg + (so + 8192u)); stR2 = *(const uint4*)(stg + (so + 16384u)); stR3 = *(const uint4*)(stg + (so + 24576u)); \
                igR0 = *(const uint4*)(igg + wo); igR1 = *(const uint4*)(igg + (wo + 1024u)); igR2 = *(const uint4*)(igg + (wo + 2048u)); igR3 = *(const uint4*)(igg + (wo + 3072u)); \
                sgR0 = *(const uint4*)(sgg + wo); sgR1 = *(const uint4*)(sgg + (wo + 1024u)); sgR2 = *(const uint4*)(sgg + (wo + 2048u)); sgR3 = *(const uint4*)(sgg + (wo + 3072u)); \
                qa0 = *(const bf16x8*)(qdg + qo); qa1 = *(const bf16x8*)(qdg + (qo + 64u)); qa2 = *(const bf16x8*)(qdg + (qo + 128u)); qa3 = *(const bf16x8*)(qdg + (qo + 192u)); }
            P4_LOADS((size_t)(chunk * 4) * 32768)
#pragma unroll
            for (int hh = 0; hh < 4; ++hh) {
                {
                    const int sr = tid >> 4, sc = tid & 15, wr = lane >> 4, wc = (lane & 15) * 16;
                    *(uint4*)(smem + swz(sr, sc)) = stR0; *(uint4*)(smem + swz(sr + 32, sc)) = stR1;
                    *(uint4*)(smem + swz(sr + 64, sc)) = stR2; *(uint4*)(smem + swz(sr + 96, sc)) = stR3;
                    *(uint4*)(igs + wr * 272 + wc) = igR0; *(uint4*)(igs + (wr + 4) * 272 + wc) = igR1;
                    *(uint4*)(igs + (wr + 8) * 272 + wc) = igR2; *(uint4*)(igs + (wr + 12) * 272 + wc) = igR3;
                    *(uint4*)(sgs + wr * 272 + wc) = sgR0; *(uint4*)(sgs + (wr + 4) * 272 + wc) = sgR1;
                    *(uint4*)(sgs + (wr + 8) * 272 + wc) = sgR2; *(uint4*)(sgs + (wr + 12) * 272 + wc) = sgR3;
                }
                lds_barrier();
                bf16x8 qc[4];
                qc[0] = qa0; qc[1] = qa1; qc[2] = qa2; qc[3] = qa3;
                P4_LOADS((size_t)(chunk * 4 + (hh < 3 ? hh + 1 : 3)) * 32768)
                f32x4 o[8];
#pragma unroll
                for (int nt = 0; nt < 8; ++nt) {
                    o[nt] = (f32x4){0.f, 0.f, 0.f, 0.f};
#pragma unroll
                    for (int ks = 0; ks < 4; ++ks) o[nt] = mfma16(qc[ks], frag(smem, nt, ks, fr, fq), o[nt]);
                }
#pragma unroll
                for (int nt = 0; nt < 8; ++nt)
#pragma unroll
                    for (int r = 0; r < 4; ++r) o[nt][r] += bf2f(*(const u16*)(igs + (fq * 4 + r) * 272 + (nt * 16 + fr) * 2));
                float gng[8];
#pragma unroll
                for (int nt = 0; nt < 8; ++nt) gng[nt] = p.gn_g[hh * 128 + nt * 16 + fr];
#pragma unroll
                for (int rp = 0; rp < 2; ++rp) {
                    float yv[2][8];
#pragma unroll
                    for (int r2 = 0; r2 < 2; ++r2) {
                        const int r = rp * 2 + r2;
                        float s = 0.f;
#pragma unroll
                        for (int nt = 0; nt < 8; ++nt) s += o[nt][r];
                        s = red16(s);
                        const float mean = s * (1.0f / 128.0f);
                        float q2 = 0.f;
#pragma unroll
                        for (int nt = 0; nt < 8; ++nt) { const float dv = o[nt][r] - mean; q2 += dv * dv; }
                        q2 = red16(q2);
                        const float rstd = rsqrtf(q2 * (1.0f / 128.0f) + 1e-6f);
#pragma unroll
                        for (int nt = 0; nt < 8; ++nt) {
                            const float gv = bf2f(*(const u16*)(sgs + (fq * 4 + r) * 272 + (nt * 16 + fr) * 2));
                            yv[r2][nt] = (o[nt][r] - mean) * rstd * gng[nt] * gv;
                        }
                    }
#pragma unroll
                    for (int nt = 0; nt < 8; ++nt)
                        *(uint32_t*)(ys + (fq * 4 + rp * 2 + odd) * 272 + (nt * 16 + (fr & ~1)) * 2) = pair_pack(yv[0][nt], yv[1][nt], odd);
                }
                asm volatile("s_waitcnt lgkmcnt(0)" ::: "memory");
                char* yo = (char*)(Yg + (size_t)(w * 16) * 1024 + 512 + hh * 128);
#pragma unroll
                for (int i = 0; i < 4; ++i) {
                    const int row = (lane >> 4) + 4 * i, ch = lane & 15;
                    *(uint4*)(yo + (unsigned)(row * 2048 + ch * 16)) = *(const uint4*)(ys + row * 272 + ch * 16);
                }
                lds_barrier();
            }
        }
        __threadfence_block();
        __syncthreads();
        float* part = (float*)(smem + SM_SMALL);
        float* rsv = (float*)(smem + 65536);
        f32x4 acc[8][4];
        char* outb = (char*)(p.out + (size_t)chunk * 128 * 1024 + w * 64);
        const char* xb = (const char*)(p.x + (size_t)chunk * 128 * 1024 + w * 64);
        const unsigned oo = (unsigned)(fq * 16384 + fr * 4);
        u16* Zg = (u16*)(p.ws + OFF_Z) + (size_t)chunk * 128 * 512;
#define ROWSQ(HF) \
        _Pragma("unroll") for (int mt = 0; mt < 8; ++mt) \
        _Pragma("unroll") for (int r = 0; r < 4; ++r) { \
            float s = 0.f; \
            _Pragma("unroll") for (int nt = 0; nt < 4; ++nt) s += acc[mt][nt][r] * acc[mt][nt][r]; \
            s = red16(s); \
            if (fr == 0) part[((HF) * 8 + w) * 128 + mt * 16 + fq * 4 + r] = s; \
        }
        {
            const bf16x8* Bf = (const bf16x8*)(p.ws + OFF_WOUTF) + ((size_t)(0 * 8 + w) * 128) * 64;
            gemm_core<4, true>(Yg, Bf, smem, acc, (const char*)(p.x + (size_t)chunk * 128 * 1024));
            ROWSQ(0)
            char* zb = (char*)(Zg + w * 64);
            const unsigned zo = (unsigned)((fq * 4 + odd) * 1024 + (fr & ~1) * 2);
#pragma unroll
            for (int mt = 0; mt < 8; ++mt) {
                char* zm = zb + mt * 16384;
#pragma unroll
                for (int nt = 0; nt < 4; ++nt)
#pragma unroll
                    for (int rp = 0; rp < 2; ++rp)
                        *(uint32_t*)(zm + (zo + (unsigned)(rp * 2048 + nt * 32))) = pair_pack(acc[mt][nt][rp * 2], acc[mt][nt][rp * 2 + 1], odd);
            }
        }
        {
            const bf16x8* Bf = (const bf16x8*)(p.ws + OFF_WOUTF) + ((size_t)(1 * 8 + w) * 128) * 64;
            gemm_core<4>(Yg, Bf, smem, acc);
            ROWSQ(1)
        }
        __syncthreads();
        if (tid < 128) {
            float s = 0.f;
#pragma unroll
            for (int k = 0; k < 16; ++k) s += part[k * 128 + tid];
            rsv[tid] = rsqrtf(s * (1.0f / 1024.0f) + 1e-6f);
        }
        lds_barrier();
        const float* gate = (const float*)(p.ws + OFF_MOD) + b * 3072 + 2048;
        {
            float gg[4];
#pragma unroll
            for (int nt = 0; nt < 4; ++nt) { const int col = 512 + w * 64 + nt * 16 + fr; gg[nt] = gate[col] * p.g_post[col]; }
#pragma unroll
            for (int mt = 0; mt < 8; ++mt)
#pragma unroll
                for (int r = 0; r < 4; ++r) {
                    const float rs = rsv[mt * 16 + fq * 4 + r];
                    char* ob = outb + (mt * 16 + r) * 4096 + 2048;
                    const char* xr = xb + (mt * 16 + r) * 4096 + 2048;
#pragma unroll
                    for (int nt = 0; nt < 4; ++nt)
                        *(float*)(ob + (oo + (unsigned)(nt * 64))) = *(const float*)(xr + (oo + (unsigned)(nt * 64))) + gg[nt] * acc[mt][nt][r] * rs;
                }
        }
        {
            const int c8 = (tid & 63) * 8, r0 = tid >> 6;
            float gq[8];
            {
                const float4 g0 = *(const float4*)(gate + c8), g1 = *(const float4*)(gate + c8 + 4);
                const float4 p0 = *(const float4*)(p.g_post + c8), p1 = *(const float4*)(p.g_post + c8 + 4);
                gq[0] = g0.x * p0.x; gq[1] = g0.y * p0.y; gq[2] = g0.z * p0.z; gq[3] = g0.w * p0.w;
                gq[4] = g1.x * p1.x; gq[5] = g1.y * p1.y; gq[6] = g1.z * p1.z; gq[7] = g1.w * p1.w;
            }
            char* ob = (char*)(p.out + (size_t)chunk * 128 * 1024);
            const char* xr = (const char*)(p.x + (size_t)chunk * 128 * 1024);
            const char* zr = (const char*)Zg;
            const unsigned vo = (unsigned)(r0 * 4096 + c8 * 4), vz = (unsigned)(r0 * 1024 + c8 * 2);
#pragma unroll 4
            for (int i = 0; i < 16; ++i) {
                const uint4 z = *(const uint4*)(zr + (vz + (unsigned)(i * 8192)));
                const float4 x0 = *(const float4*)(xr + (vo + (unsigned)(i * 32768)));
                const float4 x1 = *(const float4*)(xr + (vo + (unsigned)(i * 32768 + 16)));
                const float rs = rsv[i * 8 + r0];
                float4 o0, o1;
                o0.x = x0.x + gq[0] * bf2f((u16)(z.x & 0xffff)) * rs; o0.y = x0.y + gq[1] * bf2f((u16)(z.x >> 16)) * rs;
                o0.z = x0.z + gq[2] * bf2f((u16)(z.y & 0xffff)) * rs; o0.w = x0.w + gq[3] * bf2f((u16)(z.y >> 16)) * rs;
                o1.x = x1.x + gq[4] * bf2f((u16)(z.z & 0xffff)) * rs; o1.y = x1.y + gq[5] * bf2f((u16)(z.z >> 16)) * rs;
                o1.z = x1.z + gq[6] * bf2f((u16)(z.w & 0xffff)) * rs; o1.w = x1.w + gq[7] * bf2f((u16)(z.w >> 16)) * rs;
                *(float4*)(ob + (vo + (unsigned)(i * 32768))) = o0;
                *(float4*)(ob + (vo + (unsigned)(i * 32768 + 16))) = o1;
            }
        }
        lds_barrier();
    }
}

#ifndef N_LAUNCHES
#define N_LAUNCHES 1
#endif

#if N_LAUNCHES == 1
__global__ void __launch_bounds__(NTHREADS) fwd(P p) {
    __shared__ __attribute__((aligned(16))) char smem[SM_TOTAL];
    const int bid = blockIdx.x, nb = gridDim.x;
    if (threadIdx.x == 0) *(uint4*)(smem + SM_BARW) = make_uint4(0u, 0u, 0u, 0u);
    __syncthreads();
    XcdBarrier xb = xcd_barrier_post((unsigned*)(p.ws + OFF_BAR), (volatile LAS unsigned*)(smem + SM_BARW));
#ifndef REP0
#define REP0 1
#define REP1 1
#define REP2 1
#define REP3 1
#define REP4 1
#endif
#pragma unroll 1
    for (int i = 0; i < REP0; ++i) phase0(p, smem, bid, nb);
    xcd_barrier(xb);
#pragma unroll 1
    for (int i = 0; i < REP1; ++i) phase1(p, bid, nb);
    xcd_barrier(xb);
#pragma unroll 1
    for (int i = 0; i < REP2; ++i) phase2(p, smem, bid, nb);
    xcd_barrier(xb);
#pragma unroll 1
    for (int i = 0; i < REP3; ++i) phase3(p, bid, nb);
    xcd_barrier(xb);
#pragma unroll 1
    for (int i = 0; i < REP4; ++i) phase45(p, smem, bid, nb);
}
#else
__global__ void __launch_bounds__(NTHREADS) k_phase0(P p) { __shared__ __attribute__((aligned(16))) char smem[SM_TOTAL]; phase0(p, smem, blockIdx.x, gridDim.x); }
__global__ void __launch_bounds__(NTHREADS) k_phase1(P p) { phase1(p, blockIdx.x, gridDim.x); }
__global__ void __launch_bounds__(NTHREADS) k_phase2(P p) { __shared__ __attribute__((aligned(16))) char smem[SM_TOTAL]; phase2(p, smem, blockIdx.x, gridDim.x); }
__global__ void __launch_bounds__(NTHREADS) k_phase3(P p) { phase3(p, blockIdx.x, gridDim.x); }
__global__ void __launch_bounds__(NTHREADS) k_phase45(P p) { __shared__ __attribute__((aligned(16))) char smem[SM_TOTAL]; phase45(p, smem, blockIdx.x, gridDim.x); }
#endif

extern "C" void kernel_launch(void* const* d_in, const int* in_sizes, int n_in, void* d_out, int out_size, void* d_ws, size_t ws_size,
                              hipStream_t stream) {
    P p{};
    p.x = (const float*)d_in[0]; p.c = (const float*)d_in[1]; p.pos = (const int*)d_in[2]; p.w_ada = (const float*)d_in[3];
    p.b_ada = (const float*)d_in[4]; p.g_pre = (const float*)d_in[5]; p.w_in = (const float*)d_in[6]; p.ln_g = (const float*)d_in[7];
    p.gws = (const float*)d_in[8]; p.gbs = (const float*)d_in[9]; p.gn_g = (const float*)d_in[10]; p.w_out = (const float*)d_in[11];
    p.g_post = (const float*)d_in[12]; p.out = (float*)d_out; p.ws = (char*)d_ws;
    p.ph_lo = 0; p.ph_hi = 5;
    const int grid = 256;
#if N_LAUNCHES == 1
    (void)hipMemsetAsync((char*)d_ws + OFF_BAR, 0, OFF_MOD + 16 * 3072 * 4, stream);
    void* args[] = {&p};
    hipError_t e = hipLaunchCooperativeKernel((const void*)fwd, dim3(grid), dim3(NTHREADS), args, 0, stream);
    if (e != hipSuccess) fprintf(stderr, "cooperative launch failed: %s\n", hipGetErrorString(e));
#else
    hipLaunchKernelGGL(k_phase0, dim3(grid), dim3(NTHREADS), 0, stream, p);
    hipLaunchKernelGGL(k_phase1, dim3(grid), dim3(NTHREADS), 0, stream, p);
    hipLaunchKernelGGL(k_phase2, dim3(grid), dim3(NTHREADS), 0, stream, p);
    hipLaunchKernelGGL(k_phase3, dim3(grid), dim3(NTHREADS), 0, stream, p);
    hipLaunchKernelGGL(k_phase45, dim3(grid), dim3(NTHREADS), 0, stream, p);
#endif
}
```

```cpp
#include <hip/hip_runtime.h>
#include <stdint.h>
#include <stdio.h>

typedef __attribute__((ext_vector_type(8))) short bf16x8;
typedef __attribute__((ext_vector_type(4))) float f32x4;
typedef unsigned short u16;
#define DEVFN __device__ __forceinline__
#define NTHREADS 512
#define LAS __attribute__((address_space(3)))

#define OFF_BAR    0ull
#define OFF_MOD    16384ull
#define OFF_WINF   262144ull
#define OFF_WOUTF  7602176ull
#define OFF_WS     9699328ull
#define OFF_H      16777216ull
#define OFF_Y      83886080ull
#define OFF_QD     150994944ull
#define OFF_SG     184549376ull
#define OFF_INTRA  218103808ull
#define OFF_KV     285212672ull
#define OFF_ST     OFF_KV
#define OFF_TAB    385875968ull
#define OFF_Z      (OFF_H + 33554432ull)

#define SM_SMALL   139264
#define SM_BARW    147456
#define SM_TOTAL   (147456 + 16)

struct P {
    const float* x; const float* c; const int* pos; const float* w_ada; const float* b_ada; const float* g_pre;
    const float* w_in; const float* ln_g; const float* gws; const float* gbs; const float* gn_g; const float* w_out;
    const float* g_post; float* out; char* ws;
    int ph_lo, ph_hi;
};

typedef __attribute__((ext_vector_type(2))) __bf16 bf2_t;
DEVFN u16 f2bf(float f) { return __builtin_bit_cast(u16, (__bf16)f); }
DEVFN float bf2f(u16 h) { return __uint_as_float(((uint32_t)h) << 16); }
DEVFN uint32_t pack2(float a, float b) { bf2_t v = {(__bf16)a, (__bf16)b}; return __builtin_bit_cast(uint32_t, v); }
DEVFN void lds_barrier() { asm volatile("s_waitcnt lgkmcnt(0)\n\ts_barrier" ::: "memory"); }
DEVFN uint2 pack4(float a, float b, float c, float d) { uint2 r; r.x = pack2(a, b); r.y = pack2(c, d); return r; }
DEVFN float silu(float x) { return x * __builtin_amdgcn_rcpf(1.0f + __expf(-x)); }
template <int CTRL> DEVFN float dppf(float v) { return __int_as_float(__builtin_amdgcn_update_dpp(0, __float_as_int(v), CTRL, 0xF, 0xF, true)); }
DEVFN float red16(float v) { v += dppf<0x128>(v); v += dppf<0x124>(v); v += dppf<0x4E>(v); v += dppf<0xB1>(v); return v; }
DEVFN float red4(float v) { v += dppf<0x4E>(v); v += dppf<0xB1>(v); return v; }
DEVFN float swap1(float v) { return __int_as_float(__builtin_amdgcn_update_dpp(0, __float_as_int(v), 0xB1, 0xF, 0xF, true)); }
DEVFN uint32_t pair_pack(float a, float b, int odd) {
    const float recv = swap1(odd ? a : b);
    return odd ? pack2(recv, b) : pack2(a, recv);
}
DEVFN int swz(int row, int chunk) { return row * 256 + ((chunk ^ (row & 15)) << 4); }
DEVFN bf16x8 frag(const char* base, int tile, int ks, int fr, int fq) {
    return *(const bf16x8*)(base + swz(tile * 16 + fr, ks * 4 + fq));
}
DEVFN f32x4 mfma16(bf16x8 a, bf16x8 b, f32x4 c) { return __builtin_amdgcn_mfma_f32_16x16x32_bf16(a, b, c, 0, 0, 0); }

#define XB_TMO      128
#define XB_XCNT(j)  (256  + 64 * (j))
#define XB_XSUB(j)  (1280 + 64 * (j))
#define XB_XGEN(j)  (2304 + 64 * (j))
#define XB_TOP      3328
#define XB_TOPGEN   3392
#define XCD_BAR_WORDS 3456
#define XB_SPIN_CAP (1u << 22)
DEVFN unsigned xb_ld(unsigned* p) { return __hip_atomic_load(p, __ATOMIC_RELAXED, __HIP_MEMORY_SCOPE_AGENT); }
DEVFN unsigned xb_add(unsigned* p, unsigned v) { return __hip_atomic_fetch_add(p, v, __ATOMIC_RELAXED, __HIP_MEMORY_SCOPE_AGENT); }
DEVFN unsigned xb_xcc_id() { return (unsigned)__builtin_amdgcn_s_getreg((3 << 11) | 20) & 0xFu; }
#define XB_SPIN(cond, bar) do { unsigned _sp = 0; while (cond) { __builtin_amdgcn_s_sleep(1); \
    if ((++_sp & 255u) == 0u) { if (xb_ld(&(bar)[XB_TMO])) break; if (_sp > XB_SPIN_CAP) { atomicAdd(&(bar)[XB_TMO], 1u); break; } } } } while (0)
struct XcdBarrier { unsigned* bar; unsigned x; volatile LAS unsigned* st; };
DEVFN XcdBarrier xcd_barrier_post(unsigned* bar, volatile LAS unsigned* st) {
    XcdBarrier b; b.bar = bar; b.x = xb_xcc_id(); b.st = st;
    if (threadIdx.x == 0) (void)xb_add(&bar[XB_XCNT(b.x)], 1u);
    return b;
}
DEVFN void xcd_barrier_complete(unsigned* bar, unsigned x, unsigned& nloc, unsigned& nx) {
    const unsigned G = gridDim.x * gridDim.y * gridDim.z;
    unsigned sum, cnt, mine, sp = 0u;
    for (;;) {
        sum = 0u; cnt = 0u; mine = 0u;
#pragma unroll
        for (unsigned j = 0; j < 16; ++j) { const unsigned c = xb_ld(&bar[XB_XCNT(j)]); sum += c; cnt += (c > 0u) ? 1u : 0u; mine = (j == x) ? c : mine; }
        if (sum == G) break;
        __builtin_amdgcn_s_sleep(1);
        if ((++sp & 255u) == 0u) { if (xb_ld(&bar[XB_TMO])) break; if (sp > XB_SPIN_CAP) { atomicAdd(&bar[XB_TMO], 1u); break; } }
    }
    nloc = mine > 0u ? mine : 1u; nx = cnt > 0u ? cnt : 1u;
}
DEVFN void xcd_barrier(const XcdBarrier& b) {
    asm volatile("s_waitcnt vmcnt(0)" ::: "memory");
    __syncthreads();
    if (threadIdx.x == 0) {
        unsigned* bar = b.bar;
        __builtin_amdgcn_s_waitcnt(0);
        unsigned nloc = b.st[0], nx = b.st[1];
        if (nloc == 0u) { xcd_barrier_complete(bar, b.x, nloc, nx); b.st[0] = nloc; b.st[1] = nx; }
        const unsigned old = xb_add(&bar[XB_XSUB(b.x)], 1u);
        const unsigned gen = old / nloc;
        if (old + 1u == (gen + 1u) * nloc) {
            __builtin_amdgcn_fence(__ATOMIC_RELEASE, "agent");
            asm volatile("s_waitcnt vmcnt(0)" ::: "memory");
            const unsigned og = xb_add(&bar[XB_TOP], 1u);
            const unsigned tg = og / nx;
            if (og + 1u == (tg + 1u) * nx) xb_add(&bar[XB_TOPGEN], 1u);
            else XB_SPIN(xb_ld(&bar[XB_TOPGEN]) == tg, bar);
            __builtin_amdgcn_fence(__ATOMIC_ACQUIRE, "agent");
            xb_add(&bar[XB_XGEN(b.x)], 1u);
            asm volatile("s_waitcnt vmcnt(0)" ::: "memory");
        } else {
            XB_SPIN(xb_ld(&bar[XB_XGEN(b.x)]) == gen, bar);
            __builtin_amdgcn_fence(__ATOMIC_ACQUIRE, "agent");
            asm volatile("s_waitcnt vmcnt(0)" ::: "memory");
        }
    }
    __syncthreads();
}

DEVFN int proj_feature(int j, int w, int nt, int c) {
    if (j < 4) return nt * 512 + j * 128 + w * 16 + c;
    const int hh = j - 4;
    if (nt < 2) return (c < 8 ? 1536 : 2048) + hh * 128 + nt * 64 + w * 8 + (c & 7);
    if (nt == 2) return 2560 + hh * 128 + w * 16 + c;
    return 3072 + hh * 128 + w * 16 + c;
}

DEVFN void phase0(const P& p, char* smem, int bid, int nb) {
    const int tid = threadIdx.x, lane = tid & 63, w = __builtin_amdgcn_readfirstlane(tid >> 6);
    const int N_MOD = 768, N_WIN = 896, N_WOUT = 256, N_WS = 16;
    const int NITEMS = N_MOD + N_WIN + N_WOUT + N_WS;
    for (int it = bid; it < NITEMS; it += nb) {
        if (it < N_MOD) {
            float* sc = (float*)smem;
            float* red = (float*)(smem + 65536);
            const int cg = it >> 3, ksp = it & 7, e0 = cg * 32, d0 = ksp * 128;
            lds_barrier();
            for (int i = tid; i < 2048; i += NTHREADS) sc[i] = silu(p.c[(i >> 7) * 1024 + d0 + (i & 127)]);
            lds_barrier();
            const int col = tid & 31, kg = tid >> 5;
            float wv[8];
#pragma unroll
            for (int q = 0; q < 8; ++q) wv[q] = p.w_ada[(size_t)(d0 + kg * 8 + q) * 3072 + e0 + col];
            float acc[16];
#pragma unroll
            for (int b = 0; b < 16; ++b) {
                float a = 0.f;
#pragma unroll
                for (int q = 0; q < 8; ++q) a += sc[b * 128 + kg * 8 + q] * wv[q];
                acc[b] = a;
            }
#pragma unroll
            for (int b = 0; b < 16; ++b) red[(kg * 16 + b) * 32 + col] = acc[b];
            lds_barrier();
            {
                const int b = tid >> 5;
                float s = (ksp == 0) ? p.b_ada[e0 + col] : 0.f;
#pragma unroll
                for (int k = 0; k < 16; ++k) s += red[(k * 16 + b) * 32 + col];
                atomicAdd((float*)(p.ws + OFF_MOD) + b * 3072 + e0 + col, s);
            }
        } else if (it < N_MOD + N_WIN) {
            const int F = (it - N_MOD) * 8 + w;
            int j, ww, ks, nt;
            if (F < 3072) { j = F / 768; int rem = F % 768; ww = rem / 96; int r2 = rem % 96; ks = r2 / 3; nt = r2 % 3; }
            else { int f2 = F - 3072; j = 4 + f2 / 1024; int rem = f2 % 1024; ww = rem / 128; int r2 = rem % 128; ks = r2 / 4; nt = r2 % 4; }
            const int f = proj_feature(j, ww, nt, lane & 15);
            const int k0 = ks * 32 + (lane >> 4) * 8;
            float v[8];
#pragma unroll
            for (int q = 0; q < 8; ++q) v[q] = p.w_in[(size_t)(k0 + q) * 3584 + f];
            uint4 o; o.x = pack2(v[0], v[1]); o.y = pack2(v[2], v[3]); o.z = pack2(v[4], v[5]); o.w = pack2(v[6], v[7]);
            ((uint4*)(p.ws + OFF_WINF))[(size_t)F * 64 + lane] = o;
        } else if (it < N_MOD + N_WIN + N_WOUT) {
            const int F = (it - N_MOD - N_WIN) * 8 + w;
            const int nt = F & 3, ks = (F >> 2) & 31, hw = F >> 7;
            const int n = hw * 64 + nt * 16 + (lane & 15);
            const int k0 = ks * 32 + (lane >> 4) * 8;
            float v[8];
#pragma unroll
            for (int q = 0; q < 8; ++q) v[q] = p.w_out[(size_t)(k0 + q) * 1024 + n];
            uint4 o; o.x = pack2(v[0], v[1]); o.y = pack2(v[2], v[3]); o.z = pack2(v[4], v[5]); o.w = pack2(v[6], v[7]);
            ((uint4*)(p.ws + OFF_WOUTF))[(size_t)F * 64 + lane] = o;
        } else {
            const int base = (it - N_MOD - N_WIN - N_WOUT) * 4096 + tid * 8;
            const int t = (base >> 7) & 127, s0 = base & 127;
            float v[8];
#pragma unroll
            for (int q = 0; q < 8; ++q) v[q] = (s0 + q <= t) ? p.gws[base + q] : 0.f;
            uint4 o; o.x = pack2(v[0], v[1]); o.y = pack2(v[2], v[3]); o.z = pack2(v[4], v[5]); o.w = pack2(v[6], v[7]);
            *(uint4*)((u16*)(p.ws + OFF_WS) + base) = o;
        }
    }
}

DEVFN void phase1(const P& p, int bid, int nb) {
    const int tid = threadIdx.x, lane = tid & 63, w = __builtin_amdgcn_readfirstlane(tid >> 6);
    const float* mod = (const float*)(p.ws + OFF_MOD);
    u16* H = (u16*)(p.ws + OFF_H);
    for (int rg = bid * 8 + w; rg < 2048; rg += nb * 8) {
        const int b = rg >> 7;

        float gs[16], sh[16];
#pragma unroll
        for (int i = 0; i < 4; ++i) {
            const int col = (i * 64 + lane) * 4;
            const float4 g = *(const float4*)(p.g_pre + col);
            const float4 s = *(const float4*)(mod + b * 3072 + 1024 + col);
            const float4 t = *(const float4*)(mod + b * 3072 + col);
            gs[i * 4 + 0] = g.x * (1.f + s.x); gs[i * 4 + 1] = g.y * (1.f + s.y); gs[i * 4 + 2] = g.z * (1.f + s.z); gs[i * 4 + 3] = g.w * (1.f + s.w);
            sh[i * 4 + 0] = t.x; sh[i * 4 + 1] = t.y; sh[i * 4 + 2] = t.z; sh[i * 4 + 3] = t.w;
        }
#pragma unroll 4
        for (int r = 0; r < 16; ++r) {
            const size_t row = (size_t)rg * 16 + r;
            const float4* xr = (const float4*)(p.x + row * 1024);
            float4 v[4];
#pragma unroll
            for (int i = 0; i < 4; ++i) v[i] = xr[i * 64 + lane];
            float ss = 0.f;
#pragma unroll
            for (int i = 0; i < 4; ++i) ss += v[i].x * v[i].x + v[i].y * v[i].y + v[i].z * v[i].z + v[i].w * v[i].w;
            ss = red16(ss); ss += __shfl_xor(ss, 16); ss += __shfl_xor(ss, 32);
            const float rs = rsqrtf(ss * (1.0f / 1024.0f) + 1e-6f);
#pragma unroll
            for (int i = 0; i < 4; ++i) {
                const uint2 o = pack4(v[i].x * rs * gs[i * 4 + 0] + sh[i * 4 + 0], v[i].y * rs * gs[i * 4 + 1] + sh[i * 4 + 1],
                                      v[i].z * rs * gs[i * 4 + 2] + sh[i * 4 + 2], v[i].w * rs * gs[i * 4 + 3] + sh[i * 4 + 3]);
                *(uint2*)(H + row * 1024 + (i * 64 + lane) * 4) = o;
            }
        }
    }
}

template <int NT>
DEVFN void gemm_step(const char* An, const char* Bn, const unsigned avo, const unsigned bvo, char* smem, const int cur, const int aw,
                     const int foff0, const int foff1, f32x4 (&acc)[8][NT], const bf16x8 (&bc)[2][NT], bf16x8 (&bn)[2][NT],
                     const uint4& w0, const uint4& w1, uint4& l0, uint4& l1) {
    {
        bf16x8 x0 = *(const bf16x8*)(smem + cur + foff0), x1 = *(const bf16x8*)(smem + cur + 2048 + foff0);
#pragma unroll
        for (int g = 0; g < 8; ++g) {
            const int ss = g >> 2, m0 = (g & 3) * 2;
            bf16x8 y0 = x0, y1 = x1;
            if (g < 7) {
                const int gn = g + 1, fo = (gn >> 2) ? foff1 : foff0, mn = (gn & 3) * 2;
                y0 = *(const bf16x8*)(smem + cur + mn * 2048 + fo);
                y1 = *(const bf16x8*)(smem + cur + (mn + 1) * 2048 + fo);
            }
            if (g == 0) l0 = *(const uint4*)(An + avo);
            if (g == 1) l1 = *(const uint4*)(An + (avo + 131072u));
            if (g < 2 * NT) bn[g / NT][g % NT] = *(const bf16x8*)(Bn + (bvo + (unsigned)(g * 1024)));
            __builtin_amdgcn_sched_barrier(0);
#pragma unroll
            for (int nt = 0; nt < NT; ++nt) {
                acc[m0][nt] = mfma16(x0, bc[ss][nt], acc[m0][nt]);
                acc[m0 + 1][nt] = mfma16(x1, bc[ss][nt], acc[m0 + 1][nt]);
            }
            x0 = y0; x1 = y1;
        }
    }
    __builtin_amdgcn_sched_barrier(0);
    *(uint4*)(smem + (cur ^ 16384) + aw) = w0;
    *(uint4*)(smem + (cur ^ 16384) + aw + 8192) = w1;
    lds_barrier();
}

template <int NT, bool PF = false>
DEVFN void gemm_core(const u16* __restrict__ A, const bf16x8* __restrict__ Bf, char* smem, f32x4 (&acc)[8][NT], const char* pf = nullptr) {
    int tid_ = threadIdx.x; asm volatile("" : "+v"(tid_));
    const int tid = tid_ & 511, lane = tid & 63;
    const int fr = lane & 15, fq = lane >> 4;
    const int ar = tid >> 3, ac = tid & 7;
    const char* Ab = (const char*)A;
    const char* Bb = (const char*)Bf;
    const unsigned avo = (unsigned)(ar * 2048 + ac * 16);
    const unsigned bvo = (unsigned)(lane * 16);
    const int aw = ar * 128 + ((ac ^ (ar & 7)) << 4);
    const int foff0 = fr * 128 + (((0 + fq) ^ (fr & 7)) << 4);
    const int foff1 = fr * 128 + (((4 + fq) ^ (fr & 7)) << 4);
#pragma unroll
    for (int mt = 0; mt < 8; ++mt)
#pragma unroll
        for (int nt = 0; nt < NT; ++nt) acc[mt][nt] = (f32x4){0.f, 0.f, 0.f, 0.f};
    uint4 ra0, ra1, rb0, rb1;
    {
        const uint4 a0 = *(const uint4*)(Ab + avo), a1 = *(const uint4*)(Ab + (avo + 131072u));
        rb0 = *(const uint4*)(Ab + 128 + avo); rb1 = *(const uint4*)(Ab + 128 + (avo + 131072u));
        *(uint4*)(smem + aw) = a0;
        *(uint4*)(smem + aw + 8192) = a1;
    }
    bf16x8 b0[2][NT], b1[2][NT];
#pragma unroll
    for (int ss = 0; ss < 2; ++ss)
#pragma unroll
        for (int nt = 0; nt < NT; ++nt) b0[ss][nt] = *(const bf16x8*)(Bb + (bvo + (unsigned)((ss * NT + nt) * 1024)));
    lds_barrier();
    const unsigned pfo = (unsigned)(((tid >> 6) * 64 + lane) * 64);
    float pfv = 0.f;
#pragma unroll 1
    for (int k2 = 0; k2 < 8; ++k2) {
        if (PF) {
            asm volatile("" :: "v"(pfv));
            const float t0 = *(const float*)(pf + (pfo + (unsigned)(k2 * 65536)));
            const float t1 = *(const float*)(pf + (pfo + (unsigned)(k2 * 65536 + 32768)));
            pfv = t0 + t1;
        }
        const int n1 = 2 * k2 + 1;
        const int n2 = k2 < 7 ? 2 * k2 + 2 : 15;
        const int n3 = k2 < 7 ? 2 * k2 + 3 : 15;
        gemm_step<NT>(Ab + n2 * 128, Bb + n1 * (2 * NT * 1024), avo, bvo, smem, 0, aw, foff0, foff1, acc, b0, b1, rb0, rb1, ra0, ra1);
        gemm_step<NT>(Ab + n3 * 128, Bb + n2 * (2 * NT * 1024), avo, bvo, smem, 16384, aw, foff0, foff1, acc, b1, b0, ra0, ra1, rb0, rb1);
    }
    if (PF) asm volatile("" :: "v"(pfv));
}

#define G_VS   0
#define G_VLT  69632
#define G_WS   102400
#define G_Y    0
DEVFN void item_gmlp(const P& p, char* smem, int chunk, int g) {
    int tid_ = threadIdx.x; asm volatile("" : "+v"(tid_)); const int tid = tid_ & 511, lane = tid & 63, w = __builtin_amdgcn_readfirstlane(tid >> 6), fr = lane & 15, fq = lane >> 4;
    float* stats = (float*)(smem + SM_SMALL);
    float* bsv = (float*)(smem + SM_SMALL + 1024);
    if (tid < 128) bsv[tid] = p.gbs[g * 128 + tid];
    f32x4 acc[8][3];
    const u16* A = (const u16*)(p.ws + OFF_H) + (size_t)chunk * 128 * 1024;
    const bf16x8* Bf = (const bf16x8*)(p.ws + OFF_WINF) + ((size_t)g * 768 + w * 96) * 64;
    gemm_core<3>(A, Bf, smem, acc);
    const int d = w * 16 + fr;
    {
        float* VS = (float*)(smem + G_VS);
#pragma unroll
        for (int mt = 0; mt < 8; ++mt)
#pragma unroll
            for (int r = 0; r < 4; ++r) VS[(mt * 16 + fq * 4 + r) * 132 + d] = acc[mt][1][r];
        const uint4* wsg = (const uint4*)((const u16*)(p.ws + OFF_WS) + g * 16384);
#pragma unroll
        for (int i = 0; i < 4; ++i) {
            const int row = (tid >> 4) + 32 * i, ch = tid & 15;
            *(uint4*)(smem + G_WS + swz(row, ch)) = wsg[row * 16 + ch];
        }
    }
    lds_barrier();
    {
        const float* VS = (const float*)(smem + G_VS);
        const int row = tid >> 2, q = tid & 3;
        float v[32];
#pragma unroll
        for (int i = 0; i < 8; ++i) {
            const float4 t4 = *(const float4*)(VS + row * 132 + q * 32 + i * 4);
            v[i * 4 + 0] = t4.x; v[i * 4 + 1] = t4.y; v[i * 4 + 2] = t4.z; v[i * 4 + 3] = t4.w;
        }
        float s = 0.f;
#pragma unroll
        for (int i = 0; i < 32; ++i) s += v[i];
        s = red4(s);
        const float mean = s * (1.0f / 128.0f);
        float q2 = 0.f;
#pragma unroll
        for (int i = 0; i < 32; ++i) { const float dv = v[i] - mean; q2 += dv * dv; }
        q2 = red4(q2);
        if (q == 0) { stats[row * 2] = mean; stats[row * 2 + 1] = rsqrtf(q2 * (1.0f / 128.0f) + 1e-6f); }
    }
    lds_barrier();
    {
        const float lg = p.ln_g[g * 128 + d];
#pragma unroll
        for (int mt = 0; mt < 8; ++mt) {
            const int s0 = mt * 16 + fq * 4;
            float o[4];
#pragma unroll
            for (int r = 0; r < 4; ++r) {
                const float2 st = *(const float2*)(stats + (s0 + r) * 2);
                o[r] = (acc[mt][1][r] - st.x) * st.y * lg;
            }
            *(uint2*)(smem + G_VLT + swz(d, s0 >> 3) + (s0 & 7) * 2) = pack4(o[0], o[1], o[2], o[3]);
        }
    }
    lds_barrier();
    {
        bf16x8 bv[4];
#pragma unroll
        for (int ks = 0; ks < 4; ++ks) bv[ks] = frag(smem + G_VLT, w, ks, fr, fq);
#pragma unroll
        for (int mt = 0; mt < 8; ++mt) {
            f32x4 m = (f32x4){0.f, 0.f, 0.f, 0.f};
#pragma unroll
            for (int ks = 0; ks < 4; ++ks)
                if (ks * 32 <= mt * 16 + 15) m = mfma16(frag(smem + G_WS, mt, ks, fr, fq), bv[ks], m);
#pragma unroll
            for (int r = 0; r < 4; ++r) {
                const int t = mt * 16 + fq * 4 + r;
                const float o = acc[mt][0][r] * (m[r] + bsv[t]) * silu(acc[mt][2][r]);
                *(u16*)(smem + G_Y + t * 272 + d * 2) = f2bf(o);
            }
        }
    }
    lds_barrier();
    {
        u16* Y = (u16*)(p.ws + OFF_Y) + (size_t)chunk * 128 * 1024 + g * 128;
#pragma unroll
        for (int i = 0; i < 4; ++i) {
            const int row = (tid >> 4) + 32 * i, ch = tid & 15;
            *(uint4*)(Y + (size_t)row * 1024 + ch * 8) = *(const uint4*)(smem + G_Y + row * 272 + ch * 16);
        }
    }
    lds_barrier();
}

#define R_Q   0
#define R_K   32768
#define R_KT  65536
#define R_VT  98304
DEVFN void item_ret(const P& p, char* smem, int chunk, int hh) {
    int tid_ = threadIdx.x; asm volatile("" : "+v"(tid_)); const int tid = tid_ & 511, lane = tid & 63, w = __builtin_amdgcn_readfirstlane(tid >> 6), fr = lane & 15, fq = lane >> 4;
    float* posf = (float*)(smem + SM_SMALL);
    float* kdec = posf + 128;
    float* qdec = posf + 256;
    const float lg = __logf(1.0f - exp2f(-5.0f - (float)hh));
    if (tid < 128) {
        posf[tid] = (float)p.pos[chunk * 128 + tid];
        kdec[tid] = expf((float)(127 - tid) * lg);
        qdec[tid] = expf((float)(tid + 1) * lg);
    }
    f32x4 acc[8][4];
    const u16* A = (const u16*)(p.ws + OFF_H) + (size_t)chunk * 128 * 1024;
    const bf16x8* Bf = (const bf16x8*)(p.ws + OFF_WINF) + ((size_t)3072 + hh * 1024 + w * 128) * 64;
    gemm_core<4>(A, Bf, smem, acc);
    const size_t base = (size_t)(chunk * 4 + hh) * 16384;
    const int odd = fr & 1;
    {
        const int isk = fr >> 3, d = w * 8 + (fr & 7), de = d & ~1;
        const float scale = isk ? 0.08838834764831845f : 1.0f;
        const float invf = 1.0f / powf(10000.0f, (float)d * (1.0f / 64.0f));
        char* RX = smem + (isk ? R_K : R_Q);
        const int e = w * 16 + fr;
        char* sgb = (char*)((u16*)(p.ws + OFF_SG) + base + w * 16);
        const unsigned lo = (unsigned)((fq * 4 + odd) * 256 + (fr & ~1) * 2);
#pragma unroll
        for (int mt = 0; mt < 8; ++mt) {
            const int t0 = mt * 16 + fq * 4;
            float r1[4], r2[4];
#pragma unroll
            for (int r = 0; r < 4; ++r) {
                const float rev = (posf[t0 + r] * invf) * 0.15915494309189535f;
                const float frv = rev - floorf(rev);
                const float cs = __builtin_amdgcn_cosf(frv) * scale, sn = __builtin_amdgcn_sinf(frv) * scale;
                const float x1 = acc[mt][0][r], x2 = acc[mt][1][r];
                r1[r] = x1 * cs - x2 * sn; r2[r] = x2 * cs + x1 * sn;
            }
            if (isk) {
                const float4 kd = *(const float4*)(kdec + t0);
                *(uint2*)(smem + R_KT + swz(d, t0 >> 3) + (t0 & 7) * 2) = pack4(r1[0] * kd.x, r1[1] * kd.y, r1[2] * kd.z, r1[3] * kd.w);
                *(uint2*)(smem + R_KT + swz(d + 64, t0 >> 3) + (t0 & 7) * 2) = pack4(r2[0] * kd.x, r2[1] * kd.y, r2[2] * kd.z, r2[3] * kd.w);
            }
#pragma unroll
            for (int rp = 0; rp < 2; ++rp) {
                const int tr = t0 + rp * 2 + odd;
                *(uint32_t*)(RX + swz(tr, de >> 3) + (de & 7) * 2) = pair_pack(r1[rp * 2], r1[rp * 2 + 1], odd);
                *(uint32_t*)(RX + swz(tr, (de + 64) >> 3) + (de & 7) * 2) = pair_pack(r2[rp * 2], r2[rp * 2 + 1], odd);
            }
            *(uint2*)(smem + R_VT + swz(e, t0 >> 3) + (t0 & 7) * 2) = pack4(acc[mt][2][0], acc[mt][2][1], acc[mt][2][2], acc[mt][2][3]);
#pragma unroll
            for (int rp = 0; rp < 2; ++rp)
                *(uint32_t*)(sgb + (lo + (unsigned)(mt * 4096 + rp * 512))) = pair_pack(silu(acc[mt][3][rp * 2]), silu(acc[mt][3][rp * 2 + 1]), odd);
        }
    }
    lds_barrier();
    uint2 sreg[8];
    {
        u16* qd = (u16*)(p.ws + OFF_QD) + base;
#pragma unroll
        for (int i = 0; i < 4; ++i) {
            const int row = (tid >> 4) + 32 * i, ch = tid & 15;
            const uint4 v = *(const uint4*)(smem + R_Q + swz(row, ch));
            const float f = qdec[row];
            uint4 o;
            o.x = pack2(bf2f((u16)(v.x & 0xffff)) * f, bf2f((u16)(v.x >> 16)) * f);
            o.y = pack2(bf2f((u16)(v.y & 0xffff)) * f, bf2f((u16)(v.y >> 16)) * f);
            o.z = pack2(bf2f((u16)(v.z & 0xffff)) * f, bf2f((u16)(v.z >> 16)) * f);
            o.w = pack2(bf2f((u16)(v.w & 0xffff)) * f, bf2f((u16)(v.w >> 16)) * f);
            *(uint4*)(qd + row * 128 + ch * 8) = o;
        }
        f32x4 kv[8], sa[8];
#pragma unroll
        for (int nt = 0; nt < 8; ++nt) { kv[nt] = (f32x4){0.f, 0.f, 0.f, 0.f}; sa[nt] = (f32x4){0.f, 0.f, 0.f, 0.f}; }
#pragma unroll
        for (int ks = 0; ks < 4; ++ks) {
            const bf16x8 av = frag(smem + R_VT, w, ks, fr, fq);
            const bf16x8 ak = frag(smem + R_K, w, ks, fr, fq);
#pragma unroll
            for (int nt = 0; nt < 8; ++nt) {
                kv[nt] = mfma16(av, frag(smem + R_KT, nt, ks, fr, fq), kv[nt]);
                if (nt >= w) sa[nt] = mfma16(ak, frag(smem + R_Q, nt, ks, fr, fq), sa[nt]);
            }
        }
        char* kvb = (char*)((u16*)(p.ws + OFF_KV) + base + w * 2048);
        const unsigned lo = (unsigned)((fq * 4 + odd) * 256 + (fr & ~1) * 2);
#pragma unroll
        for (int nt = 0; nt < 8; ++nt)
#pragma unroll
            for (int rp = 0; rp < 2; ++rp)
                *(uint32_t*)(kvb + (lo + (unsigned)(rp * 512 + nt * 32))) = pair_pack(kv[nt][rp * 2], kv[nt][rp * 2 + 1], odd);
#pragma unroll
        for (int nt = 0; nt < 8; ++nt) {
            const int t = nt * 16 + fr, s0 = w * 16 + fq * 4;
            float o[4];
#pragma unroll
            for (int r = 0; r < 4; ++r) {
                const int s = s0 + r;
                o[r] = (t >= s) ? sa[nt][r] * __expf((float)(t - s) * lg) : 0.f;
            }
            sreg[nt] = pack4(o[0], o[1], o[2], o[3]);
        }
    }
    lds_barrier();
    {
        const int s0 = w * 16 + fq * 4;
#pragma unroll
        for (int nt = 0; nt < 8; ++nt) *(uint2*)(smem + R_KT + swz(nt * 16 + fr, s0 >> 3) + (s0 & 7) * 2) = sreg[nt];
    }
    lds_barrier();
    {
        f32x4 ia[8];
#pragma unroll
        for (int nt = 0; nt < 8; ++nt) ia[nt] = (f32x4){0.f, 0.f, 0.f, 0.f};
#pragma unroll
        for (int ks = 0; ks < 4; ++ks)
            if (ks * 32 <= w * 16 + 15) {
                const bf16x8 af = frag(smem + R_KT, w, ks, fr, fq);
#pragma unroll
                for (int nt = 0; nt < 8; ++nt) ia[nt] = mfma16(af, frag(smem + R_VT, nt, ks, fr, fq), ia[nt]);
            }
        char* igb = (char*)((u16*)(p.ws + OFF_INTRA) + base + w * 2048);
        const unsigned lo = (unsigned)((fq * 4 + odd) * 256 + (fr & ~1) * 2);
#pragma unroll
        for (int nt = 0; nt < 8; ++nt)
#pragma unroll
            for (int rp = 0; rp < 2; ++rp)
                *(uint32_t*)(igb + (lo + (unsigned)(rp * 512 + nt * 32))) = pair_pack(ia[nt][rp * 2], ia[nt][rp * 2 + 1], odd);
    }
    lds_barrier();
}

DEVFN void phase2(const P& p, char* smem, int bid, int nb) {
    for (int it = bid; it < 2048; it += nb) {
        const int chunk = it & 255, i8 = it >> 8, grp = (chunk >> 3) & 1;
        const int j = (i8 >> 1) + (((i8 & 1) ^ grp) << 2);
        if (j < 4) item_gmlp(p, smem, chunk, j);
        else item_ret(p, smem, chunk, j - 4);
    }
}

DEVFN void phase3(const P& p, int bid, int nb) {
    const u16* KV = (const u16*)(p.ws + OFF_KV);
    u16* ST = (u16*)(p.ws + OFF_ST);
    for (int i = bid * NTHREADS + threadIdx.x; i < 262144; i += nb * NTHREADS) {
        const int bh = i >> 12, b = bh >> 2, h = bh & 3, off = (i & 4095) * 4;
        const float lg = __logf(1.0f - exp2f(-5.0f - (float)h));
        const float cd = expf(128.0f * lg);
        uint2 kv[15];
#pragma unroll
        for (int n = 0; n < 15; ++n) kv[n] = *(const uint2*)(KV + (size_t)((b * 16 + n) * 4 + h) * 16384 + off);
        float4 st = make_float4(0.f, 0.f, 0.f, 0.f);
#pragma unroll
        for (int n = 0; n < 16; ++n) {
            *(uint2*)(ST + (size_t)((b * 16 + n) * 4 + h) * 16384 + off) = pack4(st.x, st.y, st.z, st.w);
            if (n < 15) {
                st.x = st.x * cd + bf2f((u16)(kv[n].x & 0xffff)); st.y = st.y * cd + bf2f((u16)(kv[n].x >> 16));
                st.z = st.z * cd + bf2f((u16)(kv[n].y & 0xffff)); st.w = st.w * cd + bf2f((u16)(kv[n].y >> 16));
            }
        }
    }
}

DEVFN void phase45(const P& p, char* smem, int bid, int nb) {
    for (int chunk = bid; chunk < 256; chunk += nb) {
        int tid_ = threadIdx.x; asm volatile("" : "+v"(tid_));
        const int tid = tid_ & 511, lane = tid & 63, w = __builtin_amdgcn_readfirstlane(tid >> 6), fr = lane & 15, fq = lane >> 4;
        const int b = chunk >> 4, odd = fr & 1;
        u16* Yg = (u16*)(p.ws + OFF_Y) + (size_t)chunk * 128 * 1024;
        {
            char* igs = smem + 32768 + w * 13056;
            char* sgs = igs + 4352;
            char* ys = igs + 8704;
            const unsigned so = (unsigned)((tid >> 4) * 256 + (tid & 15) * 16);
            const unsigned wo = (unsigned)((w * 16 + (lane >> 4)) * 256 + (lane & 15) * 16);
            const unsigned qo = (unsigned)((w * 16 + fr) * 256 + fq * 16);
            uint4 stR0, stR1, stR2, stR3, igR0, igR1, igR2, igR3, sgR0, sgR1, sgR2, sgR3;
            bf16x8 qa0, qa1, qa2, qa3;
#define P4_LOADS(HB) { \
                const char* stg = p.ws + OFF_ST + (HB); const char* igg = p.ws + OFF_INTRA + (HB); const char* sgg = p.ws + OFF_SG + (HB); const char* qdg = p.ws + OFF_QD + (HB); \
                stR0 = *(const uint4*)(stg + so); stR1 = *(const uint4*)(stg + (so + 8192u)); stR2 = *(const uint4*)(stg + (so + 16384u)); stR3 = *(const uint4*)(stg + (so + 24576u)); \
                igR0 = *(const uint4*)(igg + wo); igR1 = *(const uint4*)(igg + (wo + 1024u)); igR2 = *(const uint4*)(igg + (wo + 2048u)); igR3 = *(const uint4*)(igg + (wo + 3072u)); \
                sgR0 = *(const uint4*)(sgg + wo); sgR1 = *(const uint4*)(sgg + (wo + 1024u)); sgR2 = *(const uint4*)(sgg + (wo + 2048u)); sgR3 = *(const uint4*)(sgg + (wo + 3072u)); \
                qa0 = *(const bf16x8*)(qdg + qo); qa1 = *(const bf16x8*)(qdg + (qo + 64u)); qa2 = *(const bf16x8*)(qdg + (qo + 128u)); qa3 = *(const bf16x8*)(qdg + (qo + 192u)); }
            P4_LOADS((size_t)(chunk * 4) * 32768)
#pragma unroll
            for (int hh = 0; hh < 4; ++hh) {
                {
                    const int sr = tid >> 4, sc = tid & 15, wr = lane >> 4, wc = (lane & 15) * 16;
                    *(uint4*)(smem + swz(sr, sc)) = stR0; *(uint4*)(smem + swz(sr + 32, sc)) = stR1;
                    *(uint4*)(smem + swz(sr + 64, sc)) = stR2; *(uint4*)(smem + swz(sr + 96, sc)) = stR3;
                    *(uint4*)(igs + wr * 272 + wc) = igR0; *(uint4*)(igs + (wr + 4) * 272 + wc) = igR1;
                    *(uint4*)(igs + (wr + 8) * 272 + wc) = igR2; *(uint4*)(igs + (wr + 12) * 272 + wc) = igR3;
                    *(uint4*)(sgs + wr * 272 + wc) = sgR0; *(uint4*)(sgs + (wr + 4) * 272 + wc) = sgR1;
                    *(uint4*)(sgs + (wr + 8) * 272 + wc) = sgR2; *(uint4*)(sgs + (wr + 12) * 272 + wc) = sgR3;
                }
                lds_barrier();
                bf16x8 qc[4];
                qc[0] = qa0; qc[1] = qa1; qc[2] = qa2; qc[3] = qa3;
                P4_LOADS((size_t)(chunk * 4 + (hh < 3 ? hh + 1 : 3)) * 32768)
                f32x4 o[8];
#pragma unroll
                for (int nt = 0; nt < 8; ++nt) {
                    o[nt] = (f32x4){0.f, 0.f, 0.f, 0.f};
#pragma unroll
                    for (int ks = 0; ks < 4; ++ks) o[nt] = mfma16(qc[ks], frag(smem, nt, ks, fr, fq), o[nt]);
                }
#pragma unroll
                for (int nt = 0; nt < 8; ++nt)
#pragma unroll
                    for (int r = 0; r < 4; ++r) o[nt][r] += bf2f(*(const u16*)(igs + (fq * 4 + r) * 272 + (nt * 16 + fr) * 2));
                float gng[8];
#pragma unroll
                for (int nt = 0; nt < 8; ++nt) gng[nt] = p.gn_g[hh * 128 + nt * 16 + fr];
#pragma unroll
                for (int rp = 0; rp < 2; ++rp) {
                    float yv[2][8];
#pragma unroll
                    for (int r2 = 0; r2 < 2; ++r2) {
                        const int r = rp * 2 + r2;
                        float s = 0.f;
#pragma unroll
                        for (int nt = 0; nt < 8; ++nt) s += o[nt][r];
                        s = red16(s);
                        const float mean = s * (1.0f / 128.0f);
                        float q2 = 0.f;
#pragma unroll
                        for (int nt = 0; nt < 8; ++nt) { const float dv = o[nt][r] - mean; q2 += dv * dv; }
                        q2 = red16(q2);
                        const float rstd = rsqrtf(q2 * (1.0f / 128.0f) + 1e-6f);
#pragma unroll
                        for (int nt = 0; nt < 8; ++nt) {
                            const float gv = bf2f(*(const u16*)(sgs + (fq * 4 + r) * 272 + (nt * 16 + fr) * 2));
                            yv[r2][nt] = (o[nt][r] - mean) * rstd * gng[nt] * gv;
                        }
                    }
#pragma unroll
                    for (int nt = 0; nt < 8; ++nt)
                        *(uint32_t*)(ys + (fq * 4 + rp * 2 + odd) * 272 + (nt * 16 + (fr & ~1)) * 2) = pair_pack(yv[0][nt], yv[1][nt], odd);
                }
                asm volatile("s_waitcnt lgkmcnt(0)" ::: "memory");
                char* yo = (char*)(Yg + (size_t)(w * 16) * 1024 + 512 + hh * 128);
#pragma unroll
                for (int i = 0; i < 4; ++i) {
                    const int row = (lane >> 4) + 4 * i, ch = lane & 15;
                    *(uint4*)(yo + (unsigned)(row * 2048 + ch * 16)) = *(const uint4*)(ys + row * 272 + ch * 16);
                }
                lds_barrier();
            }
        }
        __threadfence_block();
        __syncthreads();
        float* part = (float*)(smem + SM_SMALL);
        float* rsv = (float*)(smem + 65536);
        f32x4 acc[8][4];
        char* outb = (char*)(p.out + (size_t)chunk * 128 * 1024 + w * 64);
        const char* xb = (const char*)(p.x + (size_t)chunk * 128 * 1024 + w * 64);
        const unsigned oo = (unsigned)(fq * 16384 + fr * 4);
        u16* Zg = (u16*)(p.ws + OFF_Z) + (size_t)chunk * 128 * 512;
#define ROWSQ(HF) \
        _Pragma("unroll") for (int mt = 0; mt < 8; ++mt) \
        _Pragma("unroll") for (int r = 0; r < 4; ++r) { \
            float s = 0.f; \
            _Pragma("unroll") for (int nt = 0; nt < 4; ++nt) s += acc[mt][nt][r] * acc[mt][nt][r]; \
            s = red16(s); \
            if (fr == 0) part[((HF) * 8 + w) * 128 + mt * 16 + fq * 4 + r] = s; \
        }
        {
            const bf16x8* Bf = (const bf16x8*)(p.ws + OFF_WOUTF) + ((size_t)(0 * 8 + w) * 128) * 64;
            gemm_core<4, true>(Yg, Bf, smem, acc, (const char*)(p.x + (size_t)chunk * 128 * 1024));
            ROWSQ(0)
            char* zb = (char*)(Zg + w * 64);
            const unsigned zo = (unsigned)((fq * 4 + odd) * 1024 + (fr & ~1) * 2);
#pragma unroll
            for (int mt = 0; mt < 8; ++mt) {
                char* zm = zb + mt * 16384;
#pragma unroll
                for (int nt = 0; nt < 4; ++nt)
#pragma unroll
                    for (int rp = 0; rp < 2; ++rp)
                        *(uint32_t*)(zm + (zo + (unsigned)(rp * 2048 + nt * 32))) = pair_pack(acc[mt][nt][rp * 2], acc[mt][nt][rp * 2 + 1], odd);
            }
        }
        {
            const bf16x8* Bf = (const bf16x8*)(p.ws + OFF_WOUTF) + ((size_t)(1 * 8 + w) * 128) * 64;
            gemm_core<4>(Yg, Bf, smem, acc);
            ROWSQ(1)
        }
        __syncthreads();
        if (tid < 128) {
            float s = 0.f;
#pragma unroll
            for (int k = 0; k < 16; ++k) s += part[k * 128 + tid];
            rsv[tid] = rsqrtf(s * (1.0f / 1024.0f) + 1e-6f);
        }
        lds_barrier();
        const float* gate = (const float*)(p.ws + OFF_MOD) + b * 3072 + 2048;
        {
            float gg[4];
#pragma unroll
            for (int nt = 0; nt < 4; ++nt) { const int col = 512 + w * 64 + nt * 16 + fr; gg[nt] = gate[col] * p.g_post[col]; }
#pragma unroll
            for (int mt = 0; mt < 8; ++mt)
#pragma unroll
                for (int r = 0; r < 4; ++r) {
                    const float rs = rsv[mt * 16 + fq * 4 + r];
                    char* ob = outb + (mt * 16 + r) * 4096 + 2048;
                    const char* xr = xb + (mt * 16 + r) * 4096 + 2048;
#pragma unroll
                    for (int nt = 0; nt < 4; ++nt)
                        *(float*)(ob + (oo + (unsigned)(nt * 64))) = *(const float*)(xr + (oo + (unsigned)(nt * 64))) + gg[nt] * acc[mt][nt][r] * rs;
                }
        }
        {
            const int c8 = (tid & 63) * 8, r0 = tid >> 6;
            float gq[8];
            {
                const float4 g0 = *(const float4*)(gate + c8), g1 = *(const float4*)(gate + c8 + 4);
                const float4 p0 = *(const float4*)(p.g_post + c8), p1 = *(const float4*)(p.g_post + c8 + 4);
                gq[0] = g0.x * p0.x; gq[1] = g0.y * p0.y; gq[2] = g0.z * p0.z; gq[3] = g0.w * p0.w;
                gq[4] = g1.x * p1.x; gq[5] = g1.y * p1.y; gq[6] = g1.z * p1.z; gq[7] = g1.w * p1.w;
            }
            char* ob = (char*)(p.out + (size_t)chunk * 128 * 1024);
            const char* xr = (const char*)(p.x + (size_t)chunk * 128 * 1024);
            const char* zr = (const char*)Zg;
            const unsigned vo = (unsigned)(r0 * 4096 + c8 * 4), vz = (unsigned)(r0 * 1024 + c8 * 2);
#pragma unroll 4
            for (int i = 0; i < 16; ++i) {
                const uint4 z = *(const uint4*)(zr + (vz + (unsigned)(i * 8192)));
                const float4 x0 = *(const float4*)(xr + (vo + (unsigned)(i * 32768)));
                const float4 x1 = *(const float4*)(xr + (vo + (unsigned)(i * 32768 + 16)));
                const float rs = rsv[i * 8 + r0];
                float4 o0, o1;
                o0.x = x0.x + gq[0] * bf2f((u16)(z.x & 0xffff)) * rs; o0.y = x0.y + gq[1] * bf2f((u16)(z.x >> 16)) * rs;
                o0.z = x0.z + gq[2] * bf2f((u16)(z.y & 0xffff)) * rs; o0.w = x0.w + gq[3] * bf2f((u16)(z.y >> 16)) * rs;
                o1.x = x1.x + gq[4] * bf2f((u16)(z.z & 0xffff)) * rs; o1.y = x1.y + gq[5] * bf2f((u16)(z.z >> 16)) * rs;
                o1.z = x1.z + gq[6] * bf2f((u16)(z.w & 0xffff)) * rs; o1.w = x1.w + gq[7] * bf2f((u16)(z.w >> 16)) * rs;
                *(float4*)(ob + (vo + (unsigned)(i * 32768))) = o0;
                *(float4*)(ob + (vo + (unsigned)(i * 32768 + 16))) = o1;
            }
        }
        lds_barrier();
    }
}

#ifndef N_LAUNCHES
#define N_LAUNCHES 1
#endif

#if N_LAUNCHES == 1
__global__ void __launch_bounds__(NTHREADS) fwd(P p) {
    __shared__ __attribute__((aligned(16))) char smem[SM_TOTAL];
    const int bid = blockIdx.x, nb = gridDim.x;
    if (threadIdx.x == 0) *(uint4*)(smem + SM_BARW) = make_uint4(0u, 0u, 0u, 0u);
    __syncthreads();
    XcdBarrier xb = xcd_barrier_post((unsigned*)(p.ws + OFF_BAR), (volatile LAS unsigned*)(smem + SM_BARW));
#ifndef REP0
#define REP0 1
#define REP1 1
#define REP2 1
#define REP3 1
#define REP4 1
#endif
#pragma unroll 1
    for (int i = 0; i < REP0; ++i) phase0(p, smem, bid, nb);
    xcd_barrier(xb);
#pragma unroll 1
    for (int i = 0; i < REP1; ++i) phase1(p, bid, nb);
    xcd_barrier(xb);
#pragma unroll 1
    for (int i = 0; i < REP2; ++i) phase2(p, smem, bid, nb);
    xcd_barrier(xb);
#pragma unroll 1
    for (int i = 0; i < REP3; ++i) phase3(p, bid, nb);
    xcd_barrier(xb);
#pragma unroll 1
    for (int i = 0; i < REP4; ++i) phase45(p, smem, bid, nb);
}
#else
__global__ void __launch_bounds__(NTHREADS) k_phase0(P p) { __shared__ __attribute__((aligned(16))) char smem[SM_TOTAL]; phase0(p, smem, blockIdx.x, gridDim.x); }
__global__ void __launch_bounds__(NTHREADS) k_phase1(P p) { phase1(p, blockIdx.x, gridDim.x); }
__global__ void __launch_bounds__(NTHREADS) k_phase2(P p) { __shared__ __attribute__((aligned(16))) char smem[SM_TOTAL]; phase2(p, smem, blockIdx.x, gridDim.x); }
__global__ void __launch_bounds__(NTHREADS) k_phase3(P p) { phase3(p, blockIdx.x, gridDim.x); }
__global__ void __launch_bounds__(NTHREADS) k_phase45(P p) { __shared__ __attribute__((aligned(16))) char smem[SM_TOTAL]; phase45(p, smem, blockIdx.x, gridDim.x); }
#endif

extern "C" void kernel_launch(void* const* d_in, const int* in_sizes, int n_in, void* d_out, int out_size, void* d_ws, size_t ws_size,
                              hipStream_t stream) {
    P p{};
    p.x = (const float*)d_in[0]; p.c = (const float*)d_in[1]; p.pos = (const int*)d_in[2]; p.w_ada = (const float*)d_in[3];
    p.b_ada = (const float*)d_in[4]; p.g_pre = (const float*)d_in[5]; p.w_in = (const float*)d_in[6]; p.ln_g = (const float*)d_in[7];
    p.gws = (const float*)d_in[8]; p.gbs = (const float*)d_in[9]; p.gn_g = (const float*)d_in[10]; p.w_out = (const float*)d_in[11];
    p.g_post = (const float*)d_in[12]; p.out = (float*)d_out; p.ws = (char*)d_ws;
    p.ph_lo = 0; p.ph_hi = 5;
    const int grid = 256;
#if N_LAUNCHES == 1
    (void)hipMemsetAsync((char*)d_ws + OFF_BAR, 0, OFF_MOD + 16 * 3072 * 4, stream);
    void* args[] = {&p};
    hipError_t e = hipLaunchCooperativeKernel((const void*)fwd, dim3(grid), dim3(NTHREADS), args, 0, stream);
    if (e != hipSuccess) fprintf(stderr, "cooperative launch failed: %s\n", hipGetErrorString(e));
#else
    hipLaunchKernelGGL(k_phase0, dim3(grid), dim3(NTHREADS), 0, stream, p);
    hipLaunchKernelGGL(k_phase1, dim3(grid), dim3(NTHREADS), 0, stream, p);
    hipLaunchKernelGGL(k_phase2, dim3(grid), dim3(NTHREADS), 0, stream, p);
    hipLaunchKernelGGL(k_phase3, dim3(grid), dim3(NTHREADS), 0, stream, p);
    hipLaunchKernelGGL(k_phase45, dim3(grid), dim3(NTHREADS), 0, stream, p);
#endif
}
```

```cpp
#include <hip/hip_runtime.h>
#include <stdint.h>
#include <stdio.h>

typedef __attribute__((ext_vector_type(8))) short bf16x8;
typedef __attribute__((ext_vector_type(4))) float f32x4;
typedef unsigned short u16;
#define DEVFN __device__ __forceinline__
#define NTHREADS 512
#define LAS __attribute__((address_space(3)))

#define OFF_BAR    0ull
#define OFF_MOD    16384ull
#define OFF_WINF   262144ull
#define OFF_WOUTF  7602176ull
#define OFF_WS     9699328ull
#define OFF_H      16777216ull
#define OFF_Y      83886080ull
#define OFF_QD     150994944ull
#define OFF_SG     184549376ull
#define OFF_INTRA  218103808ull
#define OFF_KV     285212672ull
#define OFF_ST     OFF_KV
#define OFF_TAB    385875968ull
#define OFF_Z      (OFF_H + 33554432ull)

#define SM_SMALL   139264
#define SM_BARW    147456
#define SM_TOTAL   (147456 + 16)

struct P {
    const float* x; const float* c; const int* pos; const float* w_ada; const float* b_ada; const float* g_pre;
    const float* w_in; const float* ln_g; const float* gws; const float* gbs; const float* gn_g; const float* w_out;
    const float* g_post; float* out; char* ws;
    int ph_lo, ph_hi;
};

typedef __attribute__((ext_vector_type(2))) __bf16 bf2_t;
DEVFN u16 f2bf(float f) { return __builtin_bit_cast(u16, (__bf16)f); }
DEVFN float bf2f(u16 h) { return __uint_as_float(((uint32_t)h) << 16); }
DEVFN uint32_t pack2(float a, float b) { bf2_t v = {(__bf16)a, (__bf16)b}; return __builtin_bit_cast(uint32_t, v); }
DEVFN void lds_barrier() { asm volatile("s_waitcnt lgkmcnt(0)\n\ts_barrier" ::: "memory"); }
DEVFN uint2 pack4(float a, float b, float c, float d) { uint2 r; r.x = pack2(a, b); r.y = pack2(c, d); return r; }
DEVFN float silu(float x) { return x * __builtin_amdgcn_rcpf(1.0f + __expf(-x)); }
template <int CTRL> DEVFN float dppf(float v) { return __int_as_float(__builtin_amdgcn_update_dpp(0, __float_as_int(v), CTRL, 0xF, 0xF, true)); }
DEVFN float red16(float v) { v += dppf<0x128>(v); v += dppf<0x124>(v); v += dppf<0x4E>(v); v += dppf<0xB1>(v); return v; }
DEVFN float red4(float v) { v += dppf<0x4E>(v); v += dppf<0xB1>(v); return v; }
DEVFN float swap1(float v) { return __int_as_float(__builtin_amdgcn_update_dpp(0, __float_as_int(v), 0xB1, 0xF, 0xF, true)); }
DEVFN uint32_t pair_pack(float a, float b, int odd) {
    const float recv = swap1(odd ? a : b);
    return odd ? pack2(recv, b) : pack2(a, recv);
}
DEVFN int swz(int row, int chunk) { return row * 256 + ((chunk ^ (row & 15)) << 4); }
DEVFN bf16x8 frag(const char* base, int tile, int ks, int fr, int fq) {
    return *(const bf16x8*)(base + swz(tile * 16 + fr, ks * 4 + fq));
}
DEVFN f32x4 mfma16(bf16x8 a, bf16x8 b, f32x4 c) { return __builtin_amdgcn_mfma_f32_16x16x32_bf16(a, b, c, 0, 0, 0); }

#define XB_TMO      128
#define XB_XCNT(j)  (256  + 64 * (j))
#define XB_XSUB(j)  (1280 + 64 * (j))
#define XB_XGEN(j)  (2304 + 64 * (j))
#define XB_TOP      3328
#define XB_TOPGEN   3392
#define XCD_BAR_WORDS 3456
#define XB_SPIN_CAP (1u << 22)
DEVFN unsigned xb_ld(unsigned* p) { return __hip_atomic_load(p, __ATOMIC_RELAXED, __HIP_MEMORY_SCOPE_AGENT); }
DEVFN unsigned xb_add(unsigned* p, unsigned v) { return __hip_atomic_fetch_add(p, v, __ATOMIC_RELAXED, __HIP_MEMORY_SCOPE_AGENT); }
DEVFN unsigned xb_xcc_id() { return (unsigned)__builtin_amdgcn_s_getreg((3 << 11) | 20) & 0xFu; }
#define XB_SPIN(cond, bar) do { unsigned _sp = 0; while (cond) { __builtin_amdgcn_s_sleep(1); \
    if ((++_sp & 255u) == 0u) { if (xb_ld(&(bar)[XB_TMO])) break; if (_sp > XB_SPIN_CAP) { atomicAdd(&(bar)[XB_TMO], 1u); break; } } } } while (0)
struct XcdBarrier { unsigned* bar; unsigned x; volatile LAS unsigned* st; };
DEVFN XcdBarrier xcd_barrier_post(unsigned* bar, volatile LAS unsigned* st) {
    XcdBarrier b; b.bar = bar; b.x = xb_xcc_id(); b.st = st;
    if (threadIdx.x == 0) (void)xb_add(&bar[XB_XCNT(b.x)], 1u);
    return b;
}
DEVFN void xcd_barrier_complete(unsigned* bar, unsigned x, unsigned& nloc, unsigned& nx) {
    const unsigned G = gridDim.x * gridDim.y * gridDim.z;
    unsigned sum, cnt, mine, sp = 0u;
    for (;;) {
        sum = 0u; cnt = 0u; mine = 0u;
#pragma unroll
        for (unsigned j = 0; j < 16; ++j) { const unsigned c = xb_ld(&bar[XB_XCNT(j)]); sum += c; cnt += (c > 0u) ? 1u : 0u; mine = (j == x) ? c : mine; }
        if (sum == G) break;
        __builtin_amdgcn_s_sleep(1);
        if ((++sp & 255u) == 0u) { if (xb_ld(&bar[XB_TMO])) break; if (sp > XB_SPIN_CAP) { atomicAdd(&bar[XB_TMO], 1u); break; } }
    }
    nloc = mine > 0u ? mine : 1u; nx = cnt > 0u ? cnt : 1u;
}
DEVFN void xcd_barrier(const XcdBarrier& b) {
    asm volatile("s_waitcnt vmcnt(0)" ::: "memory");
    __syncthreads();
    if (threadIdx.x == 0) {
        unsigned* bar = b.bar;
        __builtin_amdgcn_s_waitcnt(0);
        unsigned nloc = b.st[0], nx = b.st[1];
        if (nloc == 0u) { xcd_barrier_complete(bar, b.x, nloc, nx); b.st[0] = nloc; b.st[1] = nx; }
        const unsigned old = xb_add(&bar[XB_XSUB(b.x)], 1u);
        const unsigned gen = old / nloc;
        if (old + 1u == (gen + 1u) * nloc) {
            __builtin_amdgcn_fence(__ATOMIC_RELEASE, "agent");
            asm volatile("s_waitcnt vmcnt(0)" ::: "memory");
            const unsigned og = xb_add(&bar[XB_TOP], 1u);
            const unsigned tg = og / nx;
            if (og + 1u == (tg + 1u) * nx) xb_add(&bar[XB_TOPGEN], 1u);
            else XB_SPIN(xb_ld(&bar[XB_TOPGEN]) == tg, bar);
            __builtin_amdgcn_fence(__ATOMIC_ACQUIRE, "agent");
            xb_add(&bar[XB_XGEN(b.x)], 1u);
            asm volatile("s_waitcnt vmcnt(0)" ::: "memory");
        } else {
            XB_SPIN(xb_ld(&bar[XB_XGEN(b.x)]) == gen, bar);
            __builtin_amdgcn_fence(__ATOMIC_ACQUIRE, "agent");
            asm volatile("s_waitcnt vmcnt(0)" ::: "memory");
        }
    }
    __syncthreads();
}

DEVFN int proj_feature(int j, int w, int nt, int c) {
    if (j < 4) return nt * 512 + j * 128 + w * 16 + c;
    const int hh = j - 4;
    if (nt < 2) return (c < 8 ? 1536 : 2048) + hh * 128 + nt * 64 + w * 8 + (c & 7);
    if (nt == 2) return 2560 + hh * 128 + w * 16 + c;
    return 3072 + hh * 128 + w * 16 + c;
}

DEVFN void phase0(const P& p, char* smem, int bid, int nb) {
    const int tid = threadIdx.x, lane = tid & 63, w = __builtin_amdgcn_readfirstlane(tid >> 6);
    const int N_MOD = 768, N_WIN = 0, N_WOUT = 0, N_WS = 16;
    const int NITEMS = N_MOD + N_WIN + N_WOUT + N_WS;
    for (int it = bid; it < NITEMS; it += nb) {
        if (it < N_MOD) {
            float* sc = (float*)smem;
            float* red = (float*)(smem + 65536);
            const int cg = it >> 3, ksp = it & 7, e0 = cg * 32, d0 = ksp * 128;
            lds_barrier();
            for (int i = tid; i < 2048; i += NTHREADS) sc[i] = silu(p.c[(i >> 7) * 1024 + d0 + (i & 127)]);
            lds_barrier();
            const int col = tid & 31, kg = tid >> 5;
            float wv[8];
#pragma unroll
            for (int q = 0; q < 8; ++q) wv[q] = p.w_ada[(size_t)(d0 + kg * 8 + q) * 3072 + e0 + col];
            float acc[16];
#pragma unroll
            for (int b = 0; b < 16; ++b) {
                float a = 0.f;
#pragma unroll
                for (int q = 0; q < 8; ++q) a += sc[b * 128 + kg * 8 + q] * wv[q];
                acc[b] = a;
            }
#pragma unroll
            for (int b = 0; b < 16; ++b) red[(kg * 16 + b) * 32 + col] = acc[b];
            lds_barrier();
            {
                const int b = tid >> 5;
                float s = (ksp == 0) ? p.b_ada[e0 + col] : 0.f;
#pragma unroll
                for (int k = 0; k < 16; ++k) s += red[(k * 16 + b) * 32 + col];
                atomicAdd((float*)(p.ws + OFF_MOD) + b * 3072 + e0 + col, s);
            }
        } else {
            const int base = (it - N_MOD - N_WIN - N_WOUT) * 4096 + tid * 8;
            const int t = (base >> 7) & 127, s0 = base & 127;
            float v[8];
#pragma unroll
            for (int q = 0; q < 8; ++q) v[q] = (s0 + q <= t) ? p.gws[base + q] : 0.f;
            uint4 o; o.x = pack2(v[0], v[1]); o.y = pack2(v[2], v[3]); o.z = pack2(v[4], v[5]); o.w = pack2(v[6], v[7]);
            *(uint4*)((u16*)(p.ws + OFF_WS) + base) = o;
        }
    }
    {
        const int TW = nb * 8, gw = bid * 8 + w;
#pragma unroll 1
        for (int f0 = gw; f0 < 9216; f0 += 4 * TW) {
            float v[4][8];
            const float* srcp[4]; int strd[4];
#pragma unroll
            for (int u = 0; u < 4; ++u) {
                const int F = f0 + u * TW;
                const int k0 = (lane >> 4) * 8;
                if (F < 7168) {
                    int j, ww, ks, nt;
                    if (F < 3072) { j = F / 768; int rem = F % 768; ww = rem / 96; int r2 = rem % 96; ks = r2 / 3; nt = r2 % 3; }
                    else { int f2 = F - 3072; j = 4 + f2 / 1024; int rem = f2 % 1024; ww = rem / 128; int r2 = rem % 128; ks = r2 / 4; nt = r2 % 4; }
                    srcp[u] = p.w_in + (size_t)(ks * 32 + k0) * 3584 + proj_feature(j, ww, nt, lane & 15); strd[u] = 3584;
                } else {
                    const int G = (F < 9216 ? F : 9215) - 7168;
                    const int nt = G & 3, ks = (G >> 2) & 31, hw = G >> 7;
                    srcp[u] = p.w_out + (size_t)(ks * 32 + k0) * 1024 + hw * 64 + nt * 16 + (lane & 15); strd[u] = 1024;
                }
            }
#pragma unroll
            for (int u = 0; u < 4; ++u)
#pragma unroll
                for (int q = 0; q < 8; ++q) v[u][q] = srcp[u][(size_t)q * strd[u]];
#pragma unroll
            for (int u = 0; u < 4; ++u) {
                const int F = f0 + u * TW;
                uint4 o; o.x = pack2(v[u][0], v[u][1]); o.y = pack2(v[u][2], v[u][3]); o.z = pack2(v[u][4], v[u][5]); o.w = pack2(v[u][6], v[u][7]);
                if (F < 7168) ((uint4*)(p.ws + OFF_WINF))[(size_t)F * 64 + lane] = o;
                else if (F < 9216) ((uint4*)(p.ws + OFF_WOUTF))[(size_t)(F - 7168) * 64 + lane] = o;
            }
        }
    }
}

DEVFN void phase1(const P& p, int bid, int nb) {
    const int tid = threadIdx.x, lane = tid & 63, w = __builtin_amdgcn_readfirstlane(tid >> 6);
    const float* mod = (const float*)(p.ws + OFF_MOD);
    u16* H = (u16*)(p.ws + OFF_H);
    for (int rg = bid * 8 + w; rg < 2048; rg += nb * 8) {
        const int b = rg >> 7;

        float gs[16], sh[16];
#pragma unroll
        for (int i = 0; i < 4; ++i) {
            const int col = (i * 64 + lane) * 4;
            const float4 g = *(const float4*)(p.g_pre + col);
            const float4 s = *(const float4*)(mod + b * 3072 + 1024 + col);
            const float4 t = *(const float4*)(mod + b * 3072 + col);
            gs[i * 4 + 0] = g.x * (1.f + s.x); gs[i * 4 + 1] = g.y * (1.f + s.y); gs[i * 4 + 2] = g.z * (1.f + s.z); gs[i * 4 + 3] = g.w * (1.f + s.w);
            sh[i * 4 + 0] = t.x; sh[i * 4 + 1] = t.y; sh[i * 4 + 2] = t.z; sh[i * 4 + 3] = t.w;
        }
#pragma unroll 4
        for (int r = 0; r < 16; ++r) {
            const size_t row = (size_t)rg * 16 + r;
            const float4* xr = (const float4*)(p.x + row * 1024);
            float4 v[4];
#pragma unroll
            for (int i = 0; i < 4; ++i) v[i] = xr[i * 64 + lane];
            float ss = 0.f;
#pragma unroll
            for (int i = 0; i < 4; ++i) ss += v[i].x * v[i].x + v[i].y * v[i].y + v[i].z * v[i].z + v[i].w * v[i].w;
            ss = red16(ss); ss += __shfl_xor(ss, 16); ss += __shfl_xor(ss, 32);
            const float rs = rsqrtf(ss * (1.0f / 1024.0f) + 1e-6f);
#pragma unroll
            for (int i = 0; i < 4; ++i) {
                const uint2 o = pack4(v[i].x * rs * gs[i * 4 + 0] + sh[i * 4 + 0], v[i].y * rs * gs[i * 4 + 1] + sh[i * 4 + 1],
                                      v[i].z * rs * gs[i * 4 + 2] + sh[i * 4 + 2], v[i].w * rs * gs[i * 4 + 3] + sh[i * 4 + 3]);
                *(uint2*)(H + row * 1024 + (i * 64 + lane) * 4) = o;
            }
        }
    }
}

template <int NT>
DEVFN void gemm_step(const char* An, const char* Bn, const unsigned avo, const unsigned bvo, char* smem, const int cur, const int aw,
                     const int foff0, const int foff1, f32x4 (&acc)[8][NT], const bf16x8 (&bc)[2][NT], bf16x8 (&bn)[2][NT],
                     const uint4& w0, const uint4& w1, uint4& l0, uint4& l1) {
    {
        bf16x8 x0 = *(const bf16x8*)(smem + cur + foff0), x1 = *(const bf16x8*)(smem + cur + 2048 + foff0);
#pragma unroll
        for (int g = 0; g < 8; ++g) {
            const int ss = g >> 2, m0 = (g & 3) * 2;
            bf16x8 y0 = x0, y1 = x1;
            if (g < 7) {
                const int gn = g + 1, fo = (gn >> 2) ? foff1 : foff0, mn = (gn & 3) * 2;
                y0 = *(const bf16x8*)(smem + cur + mn * 2048 + fo);
                y1 = *(const bf16x8*)(smem + cur + (mn + 1) * 2048 + fo);
            }
            if (g == 0) l0 = *(const uint4*)(An + avo);
            if (g == 1) l1 = *(const uint4*)(An + (avo + 131072u));
            if (g < 2 * NT) bn[g / NT][g % NT] = *(const bf16x8*)(Bn + (bvo + (unsigned)(g * 1024)));
            __builtin_amdgcn_sched_barrier(0);
#pragma unroll
            for (int nt = 0; nt < NT; ++nt) {
                acc[m0][nt] = mfma16(x0, bc[ss][nt], acc[m0][nt]);
                acc[m0 + 1][nt] = mfma16(x1, bc[ss][nt], acc[m0 + 1][nt]);
            }
            x0 = y0; x1 = y1;
        }
    }
    __builtin_amdgcn_sched_barrier(0);
    *(uint4*)(smem + (cur ^ 16384) + aw) = w0;
    *(uint4*)(smem + (cur ^ 16384) + aw + 8192) = w1;
    lds_barrier();
}

template <int NT, bool PF = false>
DEVFN void gemm_core(const u16* __restrict__ A, const bf16x8* __restrict__ Bf, char* smem, f32x4 (&acc)[8][NT], const char* pf = nullptr) {
    int tid_ = threadIdx.x; asm volatile("" : "+v"(tid_));
    const int tid = tid_ & 511, lane = tid & 63;
    const int fr = lane & 15, fq = lane >> 4;
    const int ar = tid >> 3, ac = tid & 7;
    const char* Ab = (const char*)A;
    const char* Bb = (const char*)Bf;
    const unsigned avo = (unsigned)(ar * 2048 + ac * 16);
    const unsigned bvo = (unsigned)(lane * 16);
    const int aw = ar * 128 + ((ac ^ (ar & 7)) << 4);
    const int foff0 = fr * 128 + (((0 + fq) ^ (fr & 7)) << 4);
    const int foff1 = fr * 128 + (((4 + fq) ^ (fr & 7)) << 4);
#pragma unroll
    for (int mt = 0; mt < 8; ++mt)
#pragma unroll
        for (int nt = 0; nt < NT; ++nt) acc[mt][nt] = (f32x4){0.f, 0.f, 0.f, 0.f};
    uint4 ra0, ra1, rb0, rb1;
    {
        const uint4 a0 = *(const uint4*)(Ab + avo), a1 = *(const uint4*)(Ab + (avo + 131072u));
        rb0 = *(const uint4*)(Ab + 128 + avo); rb1 = *(const uint4*)(Ab + 128 + (avo + 131072u));
        *(uint4*)(smem + aw) = a0;
        *(uint4*)(smem + aw + 8192) = a1;
    }
    bf16x8 b0[2][NT], b1[2][NT];
#pragma unroll
    for (int ss = 0; ss < 2; ++ss)
#pragma unroll
        for (int nt = 0; nt < NT; ++nt) b0[ss][nt] = *(const bf16x8*)(Bb + (bvo + (unsigned)((ss * NT + nt) * 1024)));
    lds_barrier();
    const unsigned pfo = (unsigned)(((tid >> 6) * 64 + lane) * 64);
    float pfv = 0.f;
#pragma unroll 1
    for (int k2 = 0; k2 < 8; ++k2) {
        if (PF) {
            asm volatile("" :: "v"(pfv));
            const float t0 = *(const float*)(pf + (pfo + (unsigned)(k2 * 65536)));
            const float t1 = *(const float*)(pf + (pfo + (unsigned)(k2 * 65536 + 32768)));
            pfv = t0 + t1;
        }
        const int n1 = 2 * k2 + 1;
        const int n2 = k2 < 7 ? 2 * k2 + 2 : 15;
        const int n3 = k2 < 7 ? 2 * k2 + 3 : 15;
        gemm_step<NT>(Ab + n2 * 128, Bb + n1 * (2 * NT * 1024), avo, bvo, smem, 0, aw, foff0, foff1, acc, b0, b1, rb0, rb1, ra0, ra1);
        gemm_step<NT>(Ab + n3 * 128, Bb + n2 * (2 * NT * 1024), avo, bvo, smem, 16384, aw, foff0, foff1, acc, b1, b0, ra0, ra1, rb0, rb1);
    }
    if (PF) asm volatile("" :: "v"(pfv));
}

#define G_VS   0
#define G_VLT  69632
#define G_WS   102400
#define G_Y    0
DEVFN void item_gmlp(const P& p, char* smem, int chunk, int g) {
    int tid_ = threadIdx.x; asm volatile("" : "+v"(tid_)); const int tid = tid_ & 511, lane = tid & 63, w = __builtin_amdgcn_readfirstlane(tid >> 6), fr = lane & 15, fq = lane >> 4;
    float* stats = (float*)(smem + SM_SMALL);
    float* bsv = (float*)(smem + SM_SMALL + 1024);
    if (tid < 128) bsv[tid] = p.gbs[g * 128 + tid];
    f32x4 acc[8][3];
    const u16* A = (const u16*)(p.ws + OFF_H) + (size_t)chunk * 128 * 1024;
    const bf16x8* Bf = (const bf16x8*)(p.ws + OFF_WINF) + ((size_t)g * 768 + w * 96) * 64;
    gemm_core<3>(A, Bf, smem, acc);
    const int d = w * 16 + fr;
    {
        float* VS = (float*)(smem + G_VS);
#pragma unroll
        for (int mt = 0; mt < 8; ++mt)
#pragma unroll
            for (int r = 0; r < 4; ++r) VS[(mt * 16 + fq * 4 + r) * 132 + d] = acc[mt][1][r];
        const uint4* wsg = (const uint4*)((const u16*)(p.ws + OFF_WS) + g * 16384);
#pragma unroll
        for (int i = 0; i < 4; ++i) {
            const int row = (tid >> 4) + 32 * i, ch = tid & 15;
            *(uint4*)(smem + G_WS + swz(row, ch)) = wsg[row * 16 + ch];
        }
    }
    lds_barrier();
    {
        const float* VS = (const float*)(smem + G_VS);
        const int row = tid >> 2, q = tid & 3;
        float v[32];
#pragma unroll
        for (int i = 0; i < 8; ++i) {
            const float4 t4 = *(const float4*)(VS + row * 132 + q * 32 + i * 4);
            v[i * 4 + 0] = t4.x; v[i * 4 + 1] = t4.y; v[i * 4 + 2] = t4.z; v[i * 4 + 3] = t4.w;
        }
        float s = 0.f;
#pragma unroll
        for (int i = 0; i < 32; ++i) s += v[i];
        s = red4(s);
        const float mean = s * (1.0f / 128.0f);
        float q2 = 0.f;
#pragma unroll
        for (int i = 0; i < 32; ++i) { const float dv = v[i] - mean; q2 += dv * dv; }
        q2 = red4(q2);
        if (q == 0) { stats[row * 2] = mean; stats[row * 2 + 1] = rsqrtf(q2 * (1.0f / 128.0f) + 1e-6f); }
    }
    lds_barrier();
    {
        const float lg = p.ln_g[g * 128 + d];
#pragma unroll
        for (int mt = 0; mt < 8; ++mt) {
            const int s0 = mt * 16 + fq * 4;
            float o[4];
#pragma unroll
            for (int r = 0; r < 4; ++r) {
                const float2 st = *(const float2*)(stats + (s0 + r) * 2);
                o[r] = (acc[mt][1][r] - st.x) * st.y * lg;
            }
            *(uint2*)(smem + G_VLT + swz(d, s0 >> 3) + (s0 & 7) * 2) = pack4(o[0], o[1], o[2], o[3]);
        }
    }
    lds_barrier();
    {
        bf16x8 bv[4];
#pragma unroll
        for (int ks = 0; ks < 4; ++ks) bv[ks] = frag(smem + G_VLT, w, ks, fr, fq);
#pragma unroll
        for (int mt = 0; mt < 8; ++mt) {
            f32x4 m = (f32x4){0.f, 0.f, 0.f, 0.f};
#pragma unroll
            for (int ks = 0; ks < 4; ++ks)
                if (ks * 32 <= mt * 16 + 15) m = mfma16(frag(smem + G_WS, mt, ks, fr, fq), bv[ks], m);
#pragma unroll
            for (int r = 0; r < 4; ++r) {
                const int t = mt * 16 + fq * 4 + r;
                const float o = acc[mt][0][r] * (m[r] + bsv[t]) * silu(acc[mt][2][r]);
                *(u16*)(smem + G_Y + t * 272 + d * 2) = f2bf(o);
            }
        }
    }
    lds_barrier();
    {
        u16* Y = (u16*)(p.ws + OFF_Y) + (size_t)chunk * 128 * 1024 + g * 128;
#pragma unroll
        for (int i = 0; i < 4; ++i) {
            const int row = (tid >> 4) + 32 * i, ch = tid & 15;
            *(uint4*)(Y + (size_t)row * 1024 + ch * 8) = *(const uint4*)(smem + G_Y + row * 272 + ch * 16);
        }
    }
    lds_barrier();
}

#define R_Q   0
#define R_K   32768
#define R_KT  65536
#define R_VT  98304
DEVFN void item_ret(const P& p, char* smem, int chunk, int hh) {
    int tid_ = threadIdx.x; asm volatile("" : "+v"(tid_)); const int tid = tid_ & 511, lane = tid & 63, w = __builtin_amdgcn_readfirstlane(tid >> 6), fr = lane & 15, fq = lane >> 4;
    float* posf = (float*)(smem + SM_SMALL);
    float* kdec = posf + 128;
    float* qdec = posf + 256;
    const float lg = __logf(1.0f - exp2f(-5.0f - (float)hh));
    if (tid < 128) {
        posf[tid] = (float)p.pos[chunk * 128 + tid];
        kdec[tid] = expf((float)(127 - tid) * lg);
        qdec[tid] = expf((float)(tid + 1) * lg);
    }
    f32x4 acc[8][4];
    const u16* A = (const u16*)(p.ws + OFF_H) + (size_t)chunk * 128 * 1024;
    const bf16x8* Bf = (const bf16x8*)(p.ws + OFF_WINF) + ((size_t)3072 + hh * 1024 + w * 128) * 64;
    gemm_core<4>(A, Bf, smem, acc);
    const size_t base = (size_t)(chunk * 4 + hh) * 16384;
    const int odd = fr & 1;
    {
        const int isk = fr >> 3, d = w * 8 + (fr & 7), de = d & ~1;
        const float scale = isk ? 0.08838834764831845f : 1.0f;
        const float invf = 1.0f / powf(10000.0f, (float)d * (1.0f / 64.0f));
        char* RX = smem + (isk ? R_K : R_Q);
        const int e = w * 16 + fr;
        char* sgb = (char*)((u16*)(p.ws + OFF_SG) + base + w * 16);
        const unsigned lo = (unsigned)((fq * 4 + odd) * 256 + (fr & ~1) * 2);
#pragma unroll
        for (int mt = 0; mt < 8; ++mt) {
            const int t0 = mt * 16 + fq * 4;
            float r1[4], r2[4];
#pragma unroll
            for (int r = 0; r < 4; ++r) {
                const float rev = (posf[t0 + r] * invf) * 0.15915494309189535f;
                const float frv = rev - floorf(rev);
                const float cs = __builtin_amdgcn_cosf(frv) * scale, sn = __builtin_amdgcn_sinf(frv) * scale;
                const float x1 = acc[mt][0][r], x2 = acc[mt][1][r];
                r1[r] = x1 * cs - x2 * sn; r2[r] = x2 * cs + x1 * sn;
            }
            if (isk) {
                const float4 kd = *(const float4*)(kdec + t0);
                *(uint2*)(smem + R_KT + swz(d, t0 >> 3) + (t0 & 7) * 2) = pack4(r1[0] * kd.x, r1[1] * kd.y, r1[2] * kd.z, r1[3] * kd.w);
                *(uint2*)(smem + R_KT + swz(d + 64, t0 >> 3) + (t0 & 7) * 2) = pack4(r2[0] * kd.x, r2[1] * kd.y, r2[2] * kd.z, r2[3] * kd.w);
            }
#pragma unroll
            for (int rp = 0; rp < 2; ++rp) {
                const int tr = t0 + rp * 2 + odd;
                *(uint32_t*)(RX + swz(tr, de >> 3) + (de & 7) * 2) = pair_pack(r1[rp * 2], r1[rp * 2 + 1], odd);
                *(uint32_t*)(RX + swz(tr, (de + 64) >> 3) + (de & 7) * 2) = pair_pack(r2[rp * 2], r2[rp * 2 + 1], odd);
            }
            *(uint2*)(smem + R_VT + swz(e, t0 >> 3) + (t0 & 7) * 2) = pack4(acc[mt][2][0], acc[mt][2][1], acc[mt][2][2], acc[mt][2][3]);
#pragma unroll
            for (int rp = 0; rp < 2; ++rp)
                *(uint32_t*)(sgb + (lo + (unsigned)(mt * 4096 + rp * 512))) = pair_pack(silu(acc[mt][3][rp * 2]), silu(acc[mt][3][rp * 2 + 1]), odd);
        }
    }
    lds_barrier();
    uint2 sreg[8];
    {
        u16* qd = (u16*)(p.ws + OFF_QD) + base;
#pragma unroll
        for (int i = 0; i < 4; ++i) {
            const int row = (tid >> 4) + 32 * i, ch = tid & 15;
            const uint4 v = *(const uint4*)(smem + R_Q + swz(row, ch));
            const float f = qdec[row];
            uint4 o;
            o.x = pack2(bf2f((u16)(v.x & 0xffff)) * f, bf2f((u16)(v.x >> 16)) * f);
            o.y = pack2(bf2f((u16)(v.y & 0xffff)) * f, bf2f((u16)(v.y >> 16)) * f);
            o.z = pack2(bf2f((u16)(v.z & 0xffff)) * f, bf2f((u16)(v.z >> 16)) * f);
            o.w = pack2(bf2f((u16)(v.w & 0xffff)) * f, bf2f((u16)(v.w >> 16)) * f);
            *(uint4*)(qd + row * 128 + ch * 8) = o;
        }
        f32x4 kv[8], sa[8];
#pragma unroll
        for (int nt = 0; nt < 8; ++nt) { kv[nt] = (f32x4){0.f, 0.f, 0.f, 0.f}; sa[nt] = (f32x4){0.f, 0.f, 0.f, 0.f}; }
#pragma unroll
        for (int ks = 0; ks < 4; ++ks) {
            const bf16x8 av = frag(smem + R_VT, w, ks, fr, fq);
            const bf16x8 ak = frag(smem + R_K, w, ks, fr, fq);
#pragma unroll
            for (int nt = 0; nt < 8; ++nt) {
                kv[nt] = mfma16(av, frag(smem + R_KT, nt, ks, fr, fq), kv[nt]);
                if (nt >= w) sa[nt] = mfma16(ak, frag(smem + R_Q, nt, ks, fr, fq), sa[nt]);
            }
        }
        char* kvb = (char*)((u16*)(p.ws + OFF_KV) + base + w * 2048);
        const unsigned lo = (unsigned)((fq * 4 + odd) * 256 + (fr & ~1) * 2);
#pragma unroll
        for (int nt = 0; nt < 8; ++nt)
#pragma unroll
            for (int rp = 0; rp < 2; ++rp)
                *(uint32_t*)(kvb + (lo + (unsigned)(rp * 512 + nt * 32))) = pair_pack(kv[nt][rp * 2], kv[nt][rp * 2 + 1], odd);
#pragma unroll
        for (int nt = 0; nt < 8; ++nt) {
            const int t = nt * 16 + fr, s0 = w * 16 + fq * 4;
            float o[4];
#pragma unroll
            for (int r = 0; r < 4; ++r) {
                const int s = s0 + r;
                o[r] = (t >= s) ? sa[nt][r] * __expf((float)(t - s) * lg) : 0.f;
            }
            sreg[nt] = pack4(o[0], o[1], o[2], o[3]);
        }
    }
    lds_barrier();
    {
        const int s0 = w * 16 + fq * 4;
#pragma unroll
        for (int nt = 0; nt < 8; ++nt) *(uint2*)(smem + R_KT + swz(nt * 16 + fr, s0 >> 3) + (s0 & 7) * 2) = sreg[nt];
    }
    lds_barrier();
    {
        f32x4 ia[8];
#pragma unroll
        for (int nt = 0; nt < 8; ++nt) ia[nt] = (f32x4){0.f, 0.f, 0.f, 0.f};
#pragma unroll
        for (int ks = 0; ks < 4; ++ks)
            if (ks * 32 <= w * 16 + 15) {
                const bf16x8 af = frag(smem + R_KT, w, ks, fr, fq);
#pragma unroll
                for (int nt = 0; nt < 8; ++nt) ia[nt] = mfma16(af, frag(smem + R_VT, nt, ks, fr, fq), ia[nt]);
            }
        char* igb = (char*)((u16*)(p.ws + OFF_INTRA) + base + w * 2048);
        const unsigned lo = (unsigned)((fq * 4 + odd) * 256 + (fr & ~1) * 2);
#pragma unroll
        for (int nt = 0; nt < 8; ++nt)
#pragma unroll
            for (int rp = 0; rp < 2; ++rp)
                *(uint32_t*)(igb + (lo + (unsigned)(rp * 512 + nt * 32))) = pair_pack(ia[nt][rp * 2], ia[nt][rp * 2 + 1], odd);
    }
    lds_barrier();
}

DEVFN void phase2(const P& p, char* smem, int bid, int nb) {
    for (int it = bid; it < 2048; it += nb) {
        const int chunk = it & 255, i8 = it >> 8, grp = (chunk >> 3) & 1;
        const int j = (i8 >> 1) + (((i8 & 1) ^ grp) << 2);
        if (j < 4) item_gmlp(p, smem, chunk, j);
        else item_ret(p, smem, chunk, j - 4);
    }
}

DEVFN void phase3(const P& p, int bid, int nb) {
    const u16* KV = (const u16*)(p.ws + OFF_KV);
    u16* ST = (u16*)(p.ws + OFF_ST);
    for (int i = bid * NTHREADS + threadIdx.x; i < 262144; i += nb * NTHREADS) {
        const int bh = i >> 12, b = bh >> 2, h = bh & 3, off = (i & 4095) * 4;
        const float lg = __logf(1.0f - exp2f(-5.0f - (float)h));
        const float cd = expf(128.0f * lg);
        uint2 kv[15];
#pragma unroll
        for (int n = 0; n < 15; ++n) kv[n] = *(const uint2*)(KV + (size_t)((b * 16 + n) * 4 + h) * 16384 + off);
        float4 st = make_float4(0.f, 0.f, 0.f, 0.f);
#pragma unroll
        for (int n = 0; n < 16; ++n) {
            *(uint2*)(ST + (size_t)((b * 16 + n) * 4 + h) * 16384 + off) = pack4(st.x, st.y, st.z, st.w);
            if (n < 15) {
                st.x = st.x * cd + bf2f((u16)(kv[n].x & 0xffff)); st.y = st.y * cd + bf2f((u16)(kv[n].x >> 16));
                st.z = st.z * cd + bf2f((u16)(kv[n].y & 0xffff)); st.w = st.w * cd + bf2f((u16)(kv[n].y >> 16));
            }
        }
    }
}

DEVFN void phase45(const P& p, char* smem, int bid, int nb) {
    for (int chunk = bid; chunk < 256; chunk += nb) {
        int tid_ = threadIdx.x; asm volatile("" : "+v"(tid_));
        const int tid = tid_ & 511, lane = tid & 63, w = __builtin_amdgcn_readfirstlane(tid >> 6), fr = lane & 15, fq = lane >> 4;
        const int b = chunk >> 4, odd = fr & 1;
        u16* Yg = (u16*)(p.ws + OFF_Y) + (size_t)chunk * 128 * 1024;
        {
            char* igs = smem + 32768 + w * 13056;
            char* sgs = igs + 4352;
            char* ys = igs + 8704;
            const unsigned so = (unsigned)((tid >> 4) * 256 + (tid & 15) * 16);
            const unsigned wo = (unsigned)((w * 16 + (lane >> 4)) * 256 + (lane & 15) * 16);
            const unsigned qo = (unsigned)((w * 16 + fr) * 256 + fq * 16);
            uint4 stR0, stR1, stR2, stR3, igR0, igR1, igR2, igR3, sgR0, sgR1, sgR2, sgR3;
            bf16x8 qa0, qa1, qa2, qa3;
#define P4_LOADS(HB) { \
                const char* stg = p.ws + OFF_ST + (HB); const char* igg = p.ws + OFF_INTRA + (HB); const char* sgg = p.ws + OFF_SG + (HB); const char* qdg = p.ws + OFF_QD + (HB); \
                stR0 = *(const uint4*)(stg + so); stR1 = *(const uint4*)(stg + (so + 8192u)); stR2 = *(const uint4*)(stg + (so + 16384u)); stR3 = *(const uint4*)(stg + (so + 24576u)); \
                igR0 = *(const uint4*)(igg + wo); igR1 = *(const uint4*)(igg + (wo + 1024u)); igR2 = *(const uint4*)(igg + (wo + 2048u)); igR3 = *(const uint4*)(igg + (wo + 3072u)); \
                sgR0 = *(const uint4*)(sgg + wo); sgR1 = *(const uint4*)(sgg + (wo + 1024u)); sgR2 = *(const uint4*)(sgg + (wo + 2048u)); sgR3 = *(const uint4*)(sgg + (wo + 3072u)); \
                qa0 = *(const bf16x8*)(qdg + qo); qa1 = *(const bf16x8*)(qdg + (qo + 64u)); qa2 = *(const bf16x8*)(qdg + (qo + 128u)); qa3 = *(const bf16x8*)(qdg + (qo + 192u)); }
            P4_LOADS((size_t)(chunk * 4) * 32768)
#pragma unroll
            for (int hh = 0; hh < 4; ++hh) {
                {
                    const int sr = tid >> 4, sc = tid & 15, wr = lane >> 4, wc = (lane & 15) * 16;
                    *(uint4*)(smem + swz(sr, sc)) = stR0; *(uint4*)(smem + swz(sr + 32, sc)) = stR1;
                    *(uint4*)(smem + swz(sr + 64, sc)) = stR2; *(uint4*)(smem + swz(sr + 96, sc)) = stR3;
                    *(uint4*)(igs + wr * 272 + wc) = igR0; *(uint4*)(igs + (wr + 4) * 272 + wc) = igR1;
                    *(uint4*)(igs + (wr + 8) * 272 + wc) = igR2; *(uint4*)(igs + (wr + 12) * 272 + wc) = igR3;
                    *(uint4*)(sgs + wr * 272 + wc) = sgR0; *(uint4*)(sgs + (wr + 4) * 272 + wc) = sgR1;
                    *(uint4*)(sgs + (wr + 8) * 272 + wc) = sgR2; *(uint4*)(sgs + (wr + 12) * 272 + wc) = sgR3;
                }
                lds_barrier();
                bf16x8 qc[4];
                qc[0] = qa0; qc[1] = qa1; qc[2] = qa2; qc[3] = qa3;
                {
                    const int sct = hh * 512 + tid;
                    const float tv = *(const float*)((const char*)Yg + (unsigned)((sct >> 4) * 2048 + (sct & 15) * 64));
                    asm volatile("" :: "v"(tv));
                }
                P4_LOADS((size_t)(chunk * 4 + (hh < 3 ? hh + 1 : 3)) * 32768)
                f32x4 o[8];
#pragma unroll
                for (int nt = 0; nt < 8; ++nt) {
                    o[nt] = (f32x4){0.f, 0.f, 0.f, 0.f};
#pragma unroll
                    for (int ks = 0; ks < 4; ++ks) o[nt] = mfma16(qc[ks], frag(smem, nt, ks, fr, fq), o[nt]);
                }
#pragma unroll
                for (int nt = 0; nt < 8; ++nt)
#pragma unroll
                    for (int r = 0; r < 4; ++r) o[nt][r] += bf2f(*(const u16*)(igs + (fq * 4 + r) * 272 + (nt * 16 + fr) * 2));
                float gng[8];
#pragma unroll
                for (int nt = 0; nt < 8; ++nt) gng[nt] = p.gn_g[hh * 128 + nt * 16 + fr];
#pragma unroll
                for (int rp = 0; rp < 2; ++rp) {
                    float yv[2][8];
#pragma unroll
                    for (int r2 = 0; r2 < 2; ++r2) {
                        const int r = rp * 2 + r2;
                        float s = 0.f;
#pragma unroll
                        for (int nt = 0; nt < 8; ++nt) s += o[nt][r];
                        s = red16(s);
                        const float mean = s * (1.0f / 128.0f);
                        float q2 = 0.f;
#pragma unroll
                        for (int nt = 0; nt < 8; ++nt) { const float dv = o[nt][r] - mean; q2 += dv * dv; }
                        q2 = red16(q2);
                        const float rstd = rsqrtf(q2 * (1.0f / 128.0f) + 1e-6f);
#pragma unroll
                        for (int nt = 0; nt < 8; ++nt) {
                            const float gv = bf2f(*(const u16*)(sgs + (fq * 4 + r) * 272 + (nt * 16 + fr) * 2));
                            yv[r2][nt] = (o[nt][r] - mean) * rstd * gng[nt] * gv;
                        }
                    }
#pragma unroll
                    for (int nt = 0; nt < 8; ++nt)
                        *(uint32_t*)(ys + (fq * 4 + rp * 2 + odd) * 272 + (nt * 16 + (fr & ~1)) * 2) = pair_pack(yv[0][nt], yv[1][nt], odd);
                }
                asm volatile("s_waitcnt lgkmcnt(0)" ::: "memory");
                char* yo = (char*)(Yg + (size_t)(w * 16) * 1024 + 512 + hh * 128);
#pragma unroll
                for (int i = 0; i < 4; ++i) {
                    const int row = (lane >> 4) + 4 * i, ch = lane & 15;
                    *(uint4*)(yo + (unsigned)(row * 2048 + ch * 16)) = *(const uint4*)(ys + row * 272 + ch * 16);
                }
                lds_barrier();
            }
        }
        __threadfence_block();
        __syncthreads();
        float* part = (float*)(smem + SM_SMALL);
        float* rsv = (float*)(smem + 65536);
        f32x4 acc[8][4];
        char* outb = (char*)(p.out + (size_t)chunk * 128 * 1024 + w * 64);
        const char* xb = (const char*)(p.x + (size_t)chunk * 128 * 1024 + w * 64);
        const unsigned oo = (unsigned)(fq * 16384 + fr * 4);
        u16* Zg = (u16*)(p.ws + OFF_Z) + (size_t)chunk * 128 * 512;
#define ROWSQ(HF) \
        _Pragma("unroll") for (int mt = 0; mt < 8; ++mt) \
        _Pragma("unroll") for (int r = 0; r < 4; ++r) { \
            float s = 0.f; \
            _Pragma("unroll") for (int nt = 0; nt < 4; ++nt) s += acc[mt][nt][r] * acc[mt][nt][r]; \
            s = red16(s); \
            if (fr == 0) part[((HF) * 8 + w) * 128 + mt * 16 + fq * 4 + r] = s; \
        }
        {
            const bf16x8* Bf = (const bf16x8*)(p.ws + OFF_WOUTF) + ((size_t)(0 * 8 + w) * 128) * 64;
            gemm_core<4, true>(Yg, Bf, smem, acc, (const char*)(p.x + (size_t)chunk * 128 * 1024));
            ROWSQ(0)
            char* zb = (char*)(Zg + w * 64);
            const unsigned zo = (unsigned)((fq * 4 + odd) * 1024 + (fr & ~1) * 2);
#pragma unroll
            for (int mt = 0; mt < 8; ++mt) {
                char* zm = zb + mt * 16384;
#pragma unroll
                for (int nt = 0; nt < 4; ++nt)
#pragma unroll
                    for (int rp = 0; rp < 2; ++rp)
                        *(uint32_t*)(zm + (zo + (unsigned)(rp * 2048 + nt * 32))) = pair_pack(acc[mt][nt][rp * 2], acc[mt][nt][rp * 2 + 1], odd);
            }
        }
        {
            const bf16x8* Bf = (const bf16x8*)(p.ws + OFF_WOUTF) + ((size_t)(1 * 8 + w) * 128) * 64;
            gemm_core<4>(Yg, Bf, smem, acc);
            ROWSQ(1)
        }
        __syncthreads();
        if (tid < 128) {
            float s = 0.f;
#pragma unroll
            for (int k = 0; k < 16; ++k) s += part[k * 128 + tid];
            rsv[tid] = rsqrtf(s * (1.0f / 1024.0f) + 1e-6f);
        }
        lds_barrier();
        const float* gate = (const float*)(p.ws + OFF_MOD) + b * 3072 + 2048;
        {
            float gg[4];
#pragma unroll
            for (int nt = 0; nt < 4; ++nt) { const int col = 512 + w * 64 + nt * 16 + fr; gg[nt] = gate[col] * p.g_post[col]; }
            const unsigned po = (unsigned)((fq * 4 + odd) * 4096 + (fr & ~1) * 4);
#pragma unroll
            for (int mt = 0; mt < 8; ++mt)
#pragma unroll
                for (int rp = 0; rp < 2; ++rp) {
                    const float rs0 = rsv[mt * 16 + fq * 4 + rp * 2], rs1 = rsv[mt * 16 + fq * 4 + rp * 2 + 1];
                    char* ob = outb + (mt * 16 + rp * 2) * 4096 + 2048;
                    const char* xr = xb + (mt * 16 + rp * 2) * 4096 + 2048;
#pragma unroll
                    for (int nt = 0; nt < 4; ++nt) {
                        const float a = gg[nt] * acc[mt][nt][rp * 2] * rs0, b2 = gg[nt] * acc[mt][nt][rp * 2 + 1] * rs1;
                        const float recv = swap1(odd ? a : b2);
                        const float2 xv = *(const float2*)(xr + (po + (unsigned)(nt * 64)));
                        float2 o;
                        o.x = xv.x + (odd ? recv : a); o.y = xv.y + (odd ? b2 : recv);
                        *(float2*)(ob + (po + (unsigned)(nt * 64))) = o;
                    }
                }
        }
        {
            const int c8 = (tid & 63) * 8, r0 = tid >> 6;
            float gq[8];
            {
                const float4 g0 = *(const float4*)(gate + c8), g1 = *(const float4*)(gate + c8 + 4);
                const float4 p0 = *(const float4*)(p.g_post + c8), p1 = *(const float4*)(p.g_post + c8 + 4);
                gq[0] = g0.x * p0.x; gq[1] = g0.y * p0.y; gq[2] = g0.z * p0.z; gq[3] = g0.w * p0.w;
                gq[4] = g1.x * p1.x; gq[5] = g1.y * p1.y; gq[6] = g1.z * p1.z; gq[7] = g1.w * p1.w;
            }
            char* ob = (char*)(p.out + (size_t)chunk * 128 * 1024);
            const char* xr = (const char*)(p.x + (size_t)chunk * 128 * 1024);
            const char* zr = (const char*)Zg;
            const unsigned vo = (unsigned)(r0 * 4096 + c8 * 4), vz = (unsigned)(r0 * 1024 + c8 * 2);
#pragma unroll 4
            for (int i = 0; i < 16; ++i) {
                const uint4 z = *(const uint4*)(zr + (vz + (unsigned)(i * 8192)));
                const float4 x0 = *(const float4*)(xr + (vo + (unsigned)(i * 32768)));
                const float4 x1 = *(const float4*)(xr + (vo + (unsigned)(i * 32768 + 16)));
                const float rs = rsv[i * 8 + r0];
                float4 o0, o1;
                o0.x = x0.x + gq[0] * bf2f((u16)(z.x & 0xffff)) * rs; o0.y = x0.y + gq[1] * bf2f((u16)(z.x >> 16)) * rs;
                o0.z = x0.z + gq[2] * bf2f((u16)(z.y & 0xffff)) * rs; o0.w = x0.w + gq[3] * bf2f((u16)(z.y >> 16)) * rs;
                o1.x = x1.x + gq[4] * bf2f((u16)(z.z & 0xffff)) * rs; o1.y = x1.y + gq[5] * bf2f((u16)(z.z >> 16)) * rs;
                o1.z = x1.z + gq[6] * bf2f((u16)(z.w & 0xffff)) * rs; o1.w = x1.w + gq[7] * bf2f((u16)(z.w >> 16)) * rs;
                *(float4*)(ob + (vo + (unsigned)(i * 32768))) = o0;
                *(float4*)(ob + (vo + (unsigned)(i * 32768 + 16))) = o1;
            }
        }
        lds_barrier();
    }
}

#ifndef N_LAUNCHES
#define N_LAUNCHES 1
#endif

#if N_LAUNCHES == 1
__global__ void __launch_bounds__(NTHREADS) fwd(P p) {
    __shared__ __attribute__((aligned(16))) char smem[SM_TOTAL];
    const int bid = blockIdx.x, nb = gridDim.x;
    if (threadIdx.x == 0) *(uint4*)(smem + SM_BARW) = make_uint4(0u, 0u, 0u, 0u);
    __syncthreads();
    XcdBarrier xb = xcd_barrier_post((unsigned*)(p.ws + OFF_BAR), (volatile LAS unsigned*)(smem + SM_BARW));
#ifndef REP0
#define REP0 1
#define REP1 1
#define REP2 1
#define REP3 1
#define REP4 1
#endif
#pragma unroll 1
    for (int i = 0; i < REP0; ++i) phase0(p, smem, bid, nb);
    xcd_barrier(xb);
#pragma unroll 1
    for (int i = 0; i < REP1; ++i) phase1(p, bid, nb);
    xcd_barrier(xb);
#pragma unroll 1
    for (int i = 0; i < REP2; ++i) phase2(p, smem, bid, nb);
    xcd_barrier(xb);
#pragma unroll 1
    for (int i = 0; i < REP3; ++i) phase3(p, bid, nb);
    xcd_barrier(xb);
#pragma unroll 1
    for (int i = 0; i < REP4; ++i) phase45(p, smem, bid, nb);
}
#else
__global__ void __launch_bounds__(NTHREADS) k_phase0(P p) { __shared__ __attribute__((aligned(16))) char smem[SM_TOTAL]; phase0(p, smem, blockIdx.x, gridDim.x); }
__global__ void __launch_bounds__(NTHREADS) k_phase1(P p) { phase1(p, blockIdx.x, gridDim.x); }
__global__ void __launch_bounds__(NTHREADS) k_phase2(P p) { __shared__ __attribute__((aligned(16))) char smem[SM_TOTAL]; phase2(p, smem, blockIdx.x, gridDim.x); }
__global__ void __launch_bounds__(NTHREADS) k_phase3(P p) { phase3(p, blockIdx.x, gridDim.x); }
__global__ void __launch_bounds__(NTHREADS) k_phase45(P p) { __shared__ __attribute__((aligned(16))) char smem[SM_TOTAL]; phase45(p, smem, blockIdx.x, gridDim.x); }
#endif

extern "C" void kernel_launch(void* const* d_in, const int* in_sizes, int n_in, void* d_out, int out_size, void* d_ws, size_t ws_size,
                              hipStream_t stream) {
    P p{};
    p.x = (const float*)d_in[0]; p.c = (const float*)d_in[1]; p.pos = (const int*)d_in[2]; p.w_ada = (const float*)d_in[3];
    p.b_ada = (const float*)d_in[4]; p.g_pre = (const float*)d_in[5]; p.w_in = (const float*)d_in[6]; p.ln_g = (const float*)d_in[7];
    p.gws = (const float*)d_in[8]; p.gbs = (const float*)d_in[9]; p.gn_g = (const float*)d_in[10]; p.w_out = (const float*)d_in[11];
    p.g_post = (const float*)d_in[12]; p.out = (float*)d_out; p.ws = (char*)d_ws;
    p.ph_lo = 0; p.ph_hi = 5;
    static int grid = 0;
    if (!grid) { int dev = 0, cus = 0; if (hipGetDevice(&dev) == hipSuccess && hipDeviceGetAttribute(&cus, hipDeviceAttributeMultiprocessorCount, dev) == hipSuccess && cus > 0) grid = cus < 256 ? cus : 256; else grid = 256; }
#if N_LAUNCHES == 1
    (void)hipMemsetAsync((char*)d_ws + OFF_BAR, 0, OFF_MOD + 16 * 3072 * 4, stream);
    void* args[] = {&p};
    hipError_t e = hipLaunchCooperativeKernel((const void*)fwd, dim3(grid), dim3(NTHREADS), args, 0, stream);
    if (e != hipSuccess) fprintf(stderr, "cooperative launch failed: %s\n", hipGetErrorString(e));
#else
    hipLaunchKernelGGL(k_phase0, dim3(grid), dim3(NTHREADS), 0, stream, p);
    hipLaunchKernelGGL(k_phase1, dim3(grid), dim3(NTHREADS), 0, stream, p);
    hipLaunchKernelGGL(k_phase2, dim3(grid), dim3(NTHREADS), 0, stream, p);
    hipLaunchKernelGGL(k_phase3, dim3(grid), dim3(NTHREADS), 0, stream, p);
    hipLaunchKernelGGL(k_phase45, dim3(grid), dim3(NTHREADS), 0, stream, p);
#endif
}
```

```cpp
#include <hip/hip_runtime.h>
#include <stdint.h>
#include <stdio.h>

typedef __attribute__((ext_vector_type(8))) short bf16x8;
typedef __attribute__((ext_vector_type(4))) float f32x4;
typedef unsigned short u16;
#define DEVFN __device__ __forceinline__
#define NTHREADS 512
#define LAS __attribute__((address_space(3)))

#define OFF_BAR    0ull
#define OFF_MOD    16384ull
#define OFF_WINF   262144ull
#define OFF_WOUTF  7602176ull
#define OFF_WS     9699328ull
#define OFF_H      16777216ull
#define OFF_Y      83886080ull
#define OFF_QD     150994944ull
#define OFF_SG     184549376ull
#define OFF_INTRA  218103808ull
#define OFF_KV     285212672ull
#define OFF_ST     OFF_KV
#define OFF_TAB    385875968ull
#define OFF_Z      (OFF_H + 33554432ull)

#define SM_SMALL   139264
#define SM_BARW    147456
#define SM_TOTAL   (147456 + 16)

struct P {
    const float* x; const float* c; const int* pos; const float* w_ada; const float* b_ada; const float* g_pre;
    const float* w_in; const float* ln_g; const float* gws; const float* gbs; const float* gn_g; const float* w_out;
    const float* g_post; float* out; char* ws;
    int ph_lo, ph_hi;
};

typedef __attribute__((ext_vector_type(2))) __bf16 bf2_t;
DEVFN u16 f2bf(float f) { return __builtin_bit_cast(u16, (__bf16)f); }
DEVFN float bf2f(u16 h) { return __uint_as_float(((uint32_t)h) << 16); }
DEVFN uint32_t pack2(float a, float b) { bf2_t v = {(__bf16)a, (__bf16)b}; return __builtin_bit_cast(uint32_t, v); }
DEVFN void lds_barrier() { asm volatile("s_waitcnt lgkmcnt(0)\n\ts_barrier" ::: "memory"); }
DEVFN uint2 pack4(float a, float b, float c, float d) { uint2 r; r.x = pack2(a, b); r.y = pack2(c, d); return r; }
DEVFN float silu(float x) { return x * __builtin_amdgcn_rcpf(1.0f + __expf(-x)); }
template <int CTRL> DEVFN float dppf(float v) { return __int_as_float(__builtin_amdgcn_update_dpp(0, __float_as_int(v), CTRL, 0xF, 0xF, true)); }
DEVFN float red16(float v) { v += dppf<0x128>(v); v += dppf<0x124>(v); v += dppf<0x4E>(v); v += dppf<0xB1>(v); return v; }
DEVFN float red4(float v) { v += dppf<0x4E>(v); v += dppf<0xB1>(v); return v; }
DEVFN float swap2(float v) { return dppf<0x4E>(v); }
DEVFN float swap1(float v) { return __int_as_float(__builtin_amdgcn_update_dpp(0, __float_as_int(v), 0xB1, 0xF, 0xF, true)); }
DEVFN uint32_t pair_pack(float a, float b, int odd) {
    const float recv = swap1(odd ? a : b);
    return odd ? pack2(recv, b) : pack2(a, recv);
}
DEVFN int swz(int row, int chunk) { return row * 256 + ((chunk ^ (row & 15)) << 4); }
DEVFN bf16x8 frag(const char* base, int tile, int ks, int fr, int fq) {
    return *(const bf16x8*)(base + swz(tile * 16 + fr, ks * 4 + fq));
}
DEVFN f32x4 mfma16(bf16x8 a, bf16x8 b, f32x4 c) { return __builtin_amdgcn_mfma_f32_16x16x32_bf16(a, b, c, 0, 0, 0); }

#define XB_TMO      128
#define XB_XCNT(j)  (256  + 64 * (j))
#define XB_XSUB(j)  (1280 + 64 * (j))
#define XB_XGEN(j)  (2304 + 64 * (j))
#define XB_TOP      3328
#define XB_TOPGEN   3392
#define XCD_BAR_WORDS 3456
#define XB_SPIN_CAP (1u << 22)
DEVFN unsigned xb_ld(unsigned* p) { return __hip_atomic_load(p, __ATOMIC_RELAXED, __HIP_MEMORY_SCOPE_AGENT); }
DEVFN unsigned xb_add(unsigned* p, unsigned v) { return __hip_atomic_fetch_add(p, v, __ATOMIC_RELAXED, __HIP_MEMORY_SCOPE_AGENT); }
DEVFN unsigned xb_xcc_id() { return (unsigned)__builtin_amdgcn_s_getreg((3 << 11) | 20) & 0xFu; }
#define XB_SPIN(cond, bar) do { unsigned _sp = 0; while (cond) { __builtin_amdgcn_s_sleep(1); \
    if ((++_sp & 255u) == 0u) { if (xb_ld(&(bar)[XB_TMO])) break; if (_sp > XB_SPIN_CAP) { atomicAdd(&(bar)[XB_TMO], 1u); break; } } } } while (0)
struct XcdBarrier { unsigned* bar; unsigned x; volatile LAS unsigned* st; };
DEVFN XcdBarrier xcd_barrier_post(unsigned* bar, volatile LAS unsigned* st) {
    XcdBarrier b; b.bar = bar; b.x = xb_xcc_id(); b.st = st;
    if (threadIdx.x == 0) (void)xb_add(&bar[XB_XCNT(b.x)], 1u);
    return b;
}
DEVFN void xcd_barrier_complete(unsigned* bar, unsigned x, unsigned& nloc, unsigned& nx) {
    const unsigned G = gridDim.x * gridDim.y * gridDim.z;
    unsigned sum, cnt, mine, sp = 0u;
    for (;;) {
        sum = 0u; cnt = 0u; mine = 0u;
#pragma unroll
        for (unsigned j = 0; j < 16; ++j) { const unsigned c = xb_ld(&bar[XB_XCNT(j)]); sum += c; cnt += (c > 0u) ? 1u : 0u; mine = (j == x) ? c : mine; }
        if (sum == G) break;
        __builtin_amdgcn_s_sleep(1);
        if ((++sp & 255u) == 0u) { if (xb_ld(&bar[XB_TMO])) break; if (sp > XB_SPIN_CAP) { atomicAdd(&bar[XB_TMO], 1u); break; } }
    }
    nloc = mine > 0u ? mine : 1u; nx = cnt > 0u ? cnt : 1u;
}
DEVFN void xcd_barrier(const XcdBarrier& b) {
    asm volatile("s_waitcnt vmcnt(0)" ::: "memory");
    __syncthreads();
    if (threadIdx.x == 0) {
        unsigned* bar = b.bar;
        __builtin_amdgcn_s_waitcnt(0);
        unsigned nloc = b.st[0], nx = b.st[1];
        if (nloc == 0u) { xcd_barrier_complete(bar, b.x, nloc, nx); b.st[0] = nloc; b.st[1] = nx; }
        const unsigned old = xb_add(&bar[XB_XSUB(b.x)], 1u);
        const unsigned gen = old / nloc;
        if (old + 1u == (gen + 1u) * nloc) {
            __builtin_amdgcn_fence(__ATOMIC_RELEASE, "agent");
            asm volatile("s_waitcnt vmcnt(0)" ::: "memory");
            const unsigned og = xb_add(&bar[XB_TOP], 1u);
            const unsigned tg = og / nx;
            if (og + 1u == (tg + 1u) * nx) xb_add(&bar[XB_TOPGEN], 1u);
            else XB_SPIN(xb_ld(&bar[XB_TOPGEN]) == tg, bar);
            __builtin_amdgcn_fence(__ATOMIC_ACQUIRE, "agent");
            xb_add(&bar[XB_XGEN(b.x)], 1u);
            asm volatile("s_waitcnt vmcnt(0)" ::: "memory");
        } else {
            XB_SPIN(xb_ld(&bar[XB_XGEN(b.x)]) == gen, bar);
            __builtin_amdgcn_fence(__ATOMIC_ACQUIRE, "agent");
            asm volatile("s_waitcnt vmcnt(0)" ::: "memory");
        }
    }
    __syncthreads();
}

DEVFN int proj_feature(int j, int w, int nt, int c) {
    if (j < 4) return nt * 512 + j * 128 + w * 16 + c;
    const int hh = j - 4;
    if (nt < 2) return (c < 8 ? 1536 : 2048) + hh * 128 + nt * 64 + w * 8 + (c & 7);
    if (nt == 2) return 2560 + hh * 128 + w * 16 + c;
    return 3072 + hh * 128 + w * 16 + c;
}

DEVFN void phase0(const P& p, char* smem, int bid, int nb) {
    const int tid = threadIdx.x, lane = tid & 63, w = __builtin_amdgcn_readfirstlane(tid >> 6);
    const int N_MOD = 768, N_WIN = 0, N_WOUT = 0, N_WS = 16;
    const int NITEMS = N_MOD + N_WIN + N_WOUT + N_WS;
    for (int it = bid; it < NITEMS; it += nb) {
        if (it < N_MOD) {
            float* sc = (float*)smem;
            float* red = (float*)(smem + 65536);
            const int cg = it >> 3, ksp = it & 7, e0 = cg * 32, d0 = ksp * 128;
            lds_barrier();
            for (int i = tid; i < 2048; i += NTHREADS) sc[i] = silu(p.c[(i >> 7) * 1024 + d0 + (i & 127)]);
            lds_barrier();
            const int col = tid & 31, kg = tid >> 5;
            float wv[8];
#pragma unroll
            for (int q = 0; q < 8; ++q) wv[q] = p.w_ada[(size_t)(d0 + kg * 8 + q) * 3072 + e0 + col];
            float acc[16];
#pragma unroll
            for (int b = 0; b < 16; ++b) {
                float a = 0.f;
#pragma unroll
                for (int q = 0; q < 8; ++q) a += sc[b * 128 + kg * 8 + q] * wv[q];
                acc[b] = a;
            }
#pragma unroll
            for (int b = 0; b < 16; ++b) red[(kg * 16 + b) * 32 + col] = acc[b];
            lds_barrier();
            {
                const int b = tid >> 5;
                float s = (ksp == 0) ? p.b_ada[e0 + col] : 0.f;
#pragma unroll
                for (int k = 0; k < 16; ++k) s += red[(k * 16 + b) * 32 + col];
                atomicAdd((float*)(p.ws + OFF_MOD) + b * 3072 + e0 + col, s);
            }
        } else {
            const int base = (it - N_MOD - N_WIN - N_WOUT) * 4096 + tid * 8;
            const int t = (base >> 7) & 127, s0 = base & 127;
            float v[8];
#pragma unroll
            for (int q = 0; q < 8; ++q) v[q] = (s0 + q <= t) ? p.gws[base + q] : 0.f;
            uint4 o; o.x = pack2(v[0], v[1]); o.y = pack2(v[2], v[3]); o.z = pack2(v[4], v[5]); o.w = pack2(v[6], v[7]);
            *(uint4*)((u16*)(p.ws + OFF_WS) + base) = o;
        }
    }
    {
        const int TW = nb * 8, gw = bid * 8 + w;
#pragma unroll 1
        for (int f0 = gw; f0 < 9216; f0 += 4 * TW) {
            float v[4][8];
            const float* srcp[4]; int strd[4];
#pragma unroll
            for (int u = 0; u < 4; ++u) {
                const int F = f0 + u * TW;
                const int k0 = (lane >> 4) * 8;
                if (F < 7168) {
                    int j, ww, ks, nt;
                    if (F < 3072) { j = F / 768; int rem = F % 768; ww = rem / 96; int r2 = rem % 96; ks = r2 / 3; nt = r2 % 3; }
                    else { int f2 = F - 3072; j = 4 + f2 / 1024; int rem = f2 % 1024; ww = rem / 128; int r2 = rem % 128; ks = r2 / 4; nt = r2 % 4; }
                    srcp[u] = p.w_in + (size_t)(ks * 32 + k0) * 3584 + proj_feature(j, ww, nt, lane & 15); strd[u] = 3584;
                } else {
                    const int G = (F < 9216 ? F : 9215) - 7168;
                    const int nt = G & 3, ks = (G >> 2) & 31, hw = G >> 7;
                    srcp[u] = p.w_out + (size_t)(ks * 32 + k0) * 1024 + hw * 64 + nt * 16 + (lane & 15); strd[u] = 1024;
                }
            }
#pragma unroll
            for (int u = 0; u < 4; ++u)
#pragma unroll
                for (int q = 0; q < 8; ++q) v[u][q] = srcp[u][(size_t)q * strd[u]];
#pragma unroll
            for (int u = 0; u < 4; ++u) {
                const int F = f0 + u * TW;
                uint4 o; o.x = pack2(v[u][0], v[u][1]); o.y = pack2(v[u][2], v[u][3]); o.z = pack2(v[u][4], v[u][5]); o.w = pack2(v[u][6], v[u][7]);
                if (F < 7168) ((uint4*)(p.ws + OFF_WINF))[(size_t)F * 64 + lane] = o;
                else if (F < 9216) ((uint4*)(p.ws + OFF_WOUTF))[(size_t)(F - 7168) * 64 + lane] = o;
            }
        }
    }
}

DEVFN void phase1(const P& p, int bid, int nb) {
    const int tid = threadIdx.x, lane = tid & 63, w = __builtin_amdgcn_readfirstlane(tid >> 6);
    const float* mod = (const float*)(p.ws + OFF_MOD);
    u16* H = (u16*)(p.ws + OFF_H);
    for (int rg = bid * 8 + w; rg < 2048; rg += nb * 8) {
        const int b = rg >> 7;

        float gs[16], sh[16];
#pragma unroll
        for (int i = 0; i < 4; ++i) {
            const int col = (i * 64 + lane) * 4;
            const float4 g = *(const float4*)(p.g_pre + col);
            const float4 s = *(const float4*)(mod + b * 3072 + 1024 + col);
            const float4 t = *(const float4*)(mod + b * 3072 + col);
            gs[i * 4 + 0] = g.x * (1.f + s.x); gs[i * 4 + 1] = g.y * (1.f + s.y); gs[i * 4 + 2] = g.z * (1.f + s.z); gs[i * 4 + 3] = g.w * (1.f + s.w);
            sh[i * 4 + 0] = t.x; sh[i * 4 + 1] = t.y; sh[i * 4 + 2] = t.z; sh[i * 4 + 3] = t.w;
        }
#pragma unroll 4
        for (int r = 0; r < 16; ++r) {
            const size_t row = (size_t)rg * 16 + r;
            const float4* xr = (const float4*)(p.x + row * 1024);
            float4 v[4];
#pragma unroll
            for (int i = 0; i < 4; ++i) v[i] = xr[i * 64 + lane];
            float ss = 0.f;
#pragma unroll
            for (int i = 0; i < 4; ++i) ss += v[i].x * v[i].x + v[i].y * v[i].y + v[i].z * v[i].z + v[i].w * v[i].w;
            ss = red16(ss); ss += __shfl_xor(ss, 16); ss += __shfl_xor(ss, 32);
            const float rs = rsqrtf(ss * (1.0f / 1024.0f) + 1e-6f);
#pragma unroll
            for (int i = 0; i < 4; ++i) {
                const uint2 o = pack4(v[i].x * rs * gs[i * 4 + 0] + sh[i * 4 + 0], v[i].y * rs * gs[i * 4 + 1] + sh[i * 4 + 1],
                                      v[i].z * rs * gs[i * 4 + 2] + sh[i * 4 + 2], v[i].w * rs * gs[i * 4 + 3] + sh[i * 4 + 3]);
                *(uint2*)(H + row * 1024 + (i * 64 + lane) * 4) = o;
            }
        }
    }
}

template <int NT>
DEVFN void gemm_step(const char* An, const char* Bn, const unsigned avo, const unsigned bvo, char* smem, const int cur, const int aw,
                     const int foff0, const int foff1, f32x4 (&acc)[8][NT], const bf16x8 (&bc)[2][NT], bf16x8 (&bn)[2][NT],
                     const uint4& w0, const uint4& w1, uint4& l0, uint4& l1) {
    {
        bf16x8 x0 = *(const bf16x8*)(smem + cur + foff0), x1 = *(const bf16x8*)(smem + cur + 2048 + foff0);
#pragma unroll
        for (int g = 0; g < 8; ++g) {
            const int ss = g >> 2, m0 = (g & 3) * 2;
            bf16x8 y0 = x0, y1 = x1;
            if (g < 7) {
                const int gn = g + 1, fo = (gn >> 2) ? foff1 : foff0, mn = (gn & 3) * 2;
                y0 = *(const bf16x8*)(smem + cur + mn * 2048 + fo);
                y1 = *(const bf16x8*)(smem + cur + (mn + 1) * 2048 + fo);
            }
            if (g == 0) l0 = *(const uint4*)(An + avo);
            if (g == 1) l1 = *(const uint4*)(An + (avo + 131072u));
            if (g < 2 * NT) bn[g / NT][g % NT] = *(const bf16x8*)(Bn + (bvo + (unsigned)(g * 1024)));
            __builtin_amdgcn_sched_barrier(0);
#pragma unroll
            for (int nt = 0; nt < NT; ++nt) {
                acc[m0][nt] = mfma16(x0, bc[ss][nt], acc[m0][nt]);
                acc[m0 + 1][nt] = mfma16(x1, bc[ss][nt], acc[m0 + 1][nt]);
            }
            x0 = y0; x1 = y1;
        }
    }
    __builtin_amdgcn_sched_barrier(0);
    *(uint4*)(smem + (cur ^ 16384) + aw) = w0;
    *(uint4*)(smem + (cur ^ 16384) + aw + 8192) = w1;
    lds_barrier();
}

template <int NT, bool PF = false>
DEVFN void gemm_core(const u16* __restrict__ A, const bf16x8* __restrict__ Bf, char* smem, f32x4 (&acc)[8][NT], const char* pf = nullptr) {
    int tid_ = threadIdx.x; asm volatile("" : "+v"(tid_));
    const int tid = tid_ & 511, lane = tid & 63;
    const int fr = lane & 15, fq = lane >> 4;
    const int ar = tid >> 3, ac = tid & 7;
    const char* Ab = (const char*)A;
    const char* Bb = (const char*)Bf;
    const unsigned avo = (unsigned)(ar * 2048 + ac * 16);
    const unsigned bvo = (unsigned)(lane * 16);
    const int aw = ar * 128 + ((ac ^ (ar & 7)) << 4);
    const int foff0 = fr * 128 + (((0 + fq) ^ (fr & 7)) << 4);
    const int foff1 = fr * 128 + (((4 + fq) ^ (fr & 7)) << 4);
#pragma unroll
    for (int mt = 0; mt < 8; ++mt)
#pragma unroll
        for (int nt = 0; nt < NT; ++nt) acc[mt][nt] = (f32x4){0.f, 0.f, 0.f, 0.f};
    uint4 ra0, ra1, rb0, rb1;
    {
        const uint4 a0 = *(const uint4*)(Ab + avo), a1 = *(const uint4*)(Ab + (avo + 131072u));
        rb0 = *(const uint4*)(Ab + 128 + avo); rb1 = *(const uint4*)(Ab + 128 + (avo + 131072u));
        *(uint4*)(smem + aw) = a0;
        *(uint4*)(smem + aw + 8192) = a1;
    }
    bf16x8 b0[2][NT], b1[2][NT];
#pragma unroll
    for (int ss = 0; ss < 2; ++ss)
#pragma unroll
        for (int nt = 0; nt < NT; ++nt) b0[ss][nt] = *(const bf16x8*)(Bb + (bvo + (unsigned)((ss * NT + nt) * 1024)));
    lds_barrier();
    const unsigned pfo = (unsigned)(((tid >> 6) * 64 + lane) * 64);
    float pfv = 0.f;
#pragma unroll 1
    for (int k2 = 0; k2 < 8; ++k2) {
        if (PF) {
            asm volatile("" :: "v"(pfv));
            const float t0 = *(const float*)(pf + (pfo + (unsigned)(k2 * 65536)));
            const float t1 = *(const float*)(pf + (pfo + (unsigned)(k2 * 65536 + 32768)));
            pfv = t0 + t1;
        }
        const int n1 = 2 * k2 + 1;
        const int n2 = k2 < 7 ? 2 * k2 + 2 : 15;
        const int n3 = k2 < 7 ? 2 * k2 + 3 : 15;
        gemm_step<NT>(Ab + n2 * 128, Bb + n1 * (2 * NT * 1024), avo, bvo, smem, 0, aw, foff0, foff1, acc, b0, b1, rb0, rb1, ra0, ra1);
        gemm_step<NT>(Ab + n3 * 128, Bb + n2 * (2 * NT * 1024), avo, bvo, smem, 16384, aw, foff0, foff1, acc, b1, b0, ra0, ra1, rb0, rb1);
    }
    if (PF) asm volatile("" :: "v"(pfv));
}

#define G_VS   0
#define G_VLT  69632
#define G_WS   102400
#define G_Y    0
DEVFN void item_gmlp(const P& p, char* smem, int chunk, int g) {
    int tid_ = threadIdx.x; asm volatile("" : "+v"(tid_)); const int tid = tid_ & 511, lane = tid & 63, w = __builtin_amdgcn_readfirstlane(tid >> 6), fr = lane & 15, fq = lane >> 4;
    float* stats = (float*)(smem + SM_SMALL);
    float* bsv = (float*)(smem + SM_SMALL + 1024);
    if (tid < 128) bsv[tid] = p.gbs[g * 128 + tid];
    f32x4 acc[8][3];
    const u16* A = (const u16*)(p.ws + OFF_H) + (size_t)chunk * 128 * 1024;
    const bf16x8* Bf = (const bf16x8*)(p.ws + OFF_WINF) + ((size_t)g * 768 + w * 96) * 64;
    gemm_core<3>(A, Bf, smem, acc);
    const int d = w * 16 + fr;
    {
        float* VS = (float*)(smem + G_VS);
#pragma unroll
        for (int mt = 0; mt < 8; ++mt)
#pragma unroll
            for (int r = 0; r < 4; ++r) VS[(mt * 16 + fq * 4 + r) * 132 + d] = acc[mt][1][r];
        const uint4* wsg = (const uint4*)((const u16*)(p.ws + OFF_WS) + g * 16384);
#pragma unroll
        for (int i = 0; i < 4; ++i) {
            const int row = (tid >> 4) + 32 * i, ch = tid & 15;
            *(uint4*)(smem + G_WS + swz(row, ch)) = wsg[row * 16 + ch];
        }
    }
    lds_barrier();
    {
        const float* VS = (const float*)(smem + G_VS);
        const int row = tid >> 2, q = tid & 3;
        float v[32];
#pragma unroll
        for (int i = 0; i < 8; ++i) {
            const float4 t4 = *(const float4*)(VS + row * 132 + q * 32 + i * 4);
            v[i * 4 + 0] = t4.x; v[i * 4 + 1] = t4.y; v[i * 4 + 2] = t4.z; v[i * 4 + 3] = t4.w;
        }
        float s = 0.f;
#pragma unroll
        for (int i = 0; i < 32; ++i) s += v[i];
        s = red4(s);
        const float mean = s * (1.0f / 128.0f);
        float q2 = 0.f;
#pragma unroll
        for (int i = 0; i < 32; ++i) { const float dv = v[i] - mean; q2 += dv * dv; }
        q2 = red4(q2);
        if (q == 0) { stats[row * 2] = mean; stats[row * 2 + 1] = rsqrtf(q2 * (1.0f / 128.0f) + 1e-6f); }
    }
    lds_barrier();
    {
        const float lg = p.ln_g[g * 128 + d];
#pragma unroll
        for (int mt = 0; mt < 8; ++mt) {
            const int s0 = mt * 16 + fq * 4;
            float o[4];
#pragma unroll
            for (int r = 0; r < 4; ++r) {
                const float2 st = *(const float2*)(stats + (s0 + r) * 2);
                o[r] = (acc[mt][1][r] - st.x) * st.y * lg;
            }
            *(uint2*)(smem + G_VLT + swz(d, s0 >> 3) + (s0 & 7) * 2) = pack4(o[0], o[1], o[2], o[3]);
        }
    }
    lds_barrier();
    {
        bf16x8 bv[4];
#pragma unroll
        for (int ks = 0; ks < 4; ++ks) bv[ks] = frag(smem + G_VLT, w, ks, fr, fq);
#pragma unroll
        for (int mt = 0; mt < 8; ++mt) {
            f32x4 m = (f32x4){0.f, 0.f, 0.f, 0.f};
#pragma unroll
            for (int ks = 0; ks < 4; ++ks)
                if (ks * 32 <= mt * 16 + 15) m = mfma16(frag(smem + G_WS, mt, ks, fr, fq), bv[ks], m);
#pragma unroll
            for (int r = 0; r < 4; ++r) {
                const int t = mt * 16 + fq * 4 + r;
                const float o = acc[mt][0][r] * (m[r] + bsv[t]) * silu(acc[mt][2][r]);
                *(u16*)(smem + G_Y + t * 272 + d * 2) = f2bf(o);
            }
        }
    }
    lds_barrier();
    {
        u16* Y = (u16*)(p.ws + OFF_Y) + (size_t)chunk * 128 * 1024 + g * 128;
#pragma unroll
        for (int i = 0; i < 4; ++i) {
            const int row = (tid >> 4) + 32 * i, ch = tid & 15;
            *(uint4*)(Y + (size_t)row * 1024 + ch * 8) = *(const uint4*)(smem + G_Y + row * 272 + ch * 16);
        }
    }
    lds_barrier();
}

#define R_Q   0
#define R_K   32768
#define R_KT  65536
#define R_VT  98304
DEVFN void item_ret(const P& p, char* smem, int chunk, int hh) {
    int tid_ = threadIdx.x; asm volatile("" : "+v"(tid_)); const int tid = tid_ & 511, lane = tid & 63, w = __builtin_amdgcn_readfirstlane(tid >> 6), fr = lane & 15, fq = lane >> 4;
    float* posf = (float*)(smem + SM_SMALL);
    float* kdec = posf + 128;
    float* qdec = posf + 256;
    const float lg = __logf(1.0f - exp2f(-5.0f - (float)hh));
    if (tid < 128) {
        posf[tid] = (float)p.pos[chunk * 128 + tid];
        kdec[tid] = expf((float)(127 - tid) * lg);
        qdec[tid] = expf((float)(tid + 1) * lg);
    }
    f32x4 acc[8][4];
    const u16* A = (const u16*)(p.ws + OFF_H) + (size_t)chunk * 128 * 1024;
    const bf16x8* Bf = (const bf16x8*)(p.ws + OFF_WINF) + ((size_t)3072 + hh * 1024 + w * 128) * 64;
    gemm_core<4>(A, Bf, smem, acc);
    const size_t base = (size_t)(chunk * 4 + hh) * 16384;
    const int odd = fr & 1;
    {
        const int isk = fr >> 3, d = w * 8 + (fr & 7), de = d & ~1;
        const float scale = isk ? 0.08838834764831845f : 1.0f;
        const float invf = 1.0f / powf(10000.0f, (float)d * (1.0f / 64.0f));
        char* RX = smem + (isk ? R_K : R_Q);
        const int e = w * 16 + fr;
        char* sgb = (char*)((u16*)(p.ws + OFF_SG) + base + w * 16);
        const unsigned lo = (unsigned)((fq * 4 + odd) * 256 + (fr & ~1) * 2);
#pragma unroll
        for (int mt = 0; mt < 8; ++mt) {
            const int t0 = mt * 16 + fq * 4;
            float r1[4], r2[4];
#pragma unroll
            for (int r = 0; r < 4; ++r) {
                const float rev = (posf[t0 + r] * invf) * 0.15915494309189535f;
                const float frv = rev - floorf(rev);
                const float cs = __builtin_amdgcn_cosf(frv) * scale, sn = __builtin_amdgcn_sinf(frv) * scale;
                const float x1 = acc[mt][0][r], x2 = acc[mt][1][r];
                r1[r] = x1 * cs - x2 * sn; r2[r] = x2 * cs + x1 * sn;
            }
            if (isk) {
                const float4 kd = *(const float4*)(kdec + t0);
                *(uint2*)(smem + R_KT + swz(d, t0 >> 3) + (t0 & 7) * 2) = pack4(r1[0] * kd.x, r1[1] * kd.y, r1[2] * kd.z, r1[3] * kd.w);
                *(uint2*)(smem + R_KT + swz(d + 64, t0 >> 3) + (t0 & 7) * 2) = pack4(r2[0] * kd.x, r2[1] * kd.y, r2[2] * kd.z, r2[3] * kd.w);
            }
#pragma unroll
            for (int rp = 0; rp < 2; ++rp) {
                const int tr = t0 + rp * 2 + odd;
                *(uint32_t*)(RX + swz(tr, de >> 3) + (de & 7) * 2) = pair_pack(r1[rp * 2], r1[rp * 2 + 1], odd);
                *(uint32_t*)(RX + swz(tr, (de + 64) >> 3) + (de & 7) * 2) = pair_pack(r2[rp * 2], r2[rp * 2 + 1], odd);
            }
            *(uint2*)(smem + R_VT + swz(e, t0 >> 3) + (t0 & 7) * 2) = pack4(acc[mt][2][0], acc[mt][2][1], acc[mt][2][2], acc[mt][2][3]);
#pragma unroll
            for (int rp = 0; rp < 2; ++rp)
                *(uint32_t*)(sgb + (lo + (unsigned)(mt * 4096 + rp * 512))) = pair_pack(silu(acc[mt][3][rp * 2]), silu(acc[mt][3][rp * 2 + 1]), odd);
        }
    }
    lds_barrier();
    uint2 sreg[8];
    {
        u16* qd = (u16*)(p.ws + OFF_QD) + base;
#pragma unroll
        for (int i = 0; i < 4; ++i) {
            const int row = (tid >> 4) + 32 * i, ch = tid & 15;
            const uint4 v = *(const uint4*)(smem + R_Q + swz(row, ch));
            const float f = qdec[row];
            uint4 o;
            o.x = pack2(bf2f((u16)(v.x & 0xffff)) * f, bf2f((u16)(v.x >> 16)) * f);
            o.y = pack2(bf2f((u16)(v.y & 0xffff)) * f, bf2f((u16)(v.y >> 16)) * f);
            o.z = pack2(bf2f((u16)(v.z & 0xffff)) * f, bf2f((u16)(v.z >> 16)) * f);
            o.w = pack2(bf2f((u16)(v.w & 0xffff)) * f, bf2f((u16)(v.w >> 16)) * f);
            *(uint4*)(qd + row * 128 + ch * 8) = o;
        }
        f32x4 kv[8], sa[8];
#pragma unroll
        for (int nt = 0; nt < 8; ++nt) { kv[nt] = (f32x4){0.f, 0.f, 0.f, 0.f}; sa[nt] = (f32x4){0.f, 0.f, 0.f, 0.f}; }
#pragma unroll
        for (int ks = 0; ks < 4; ++ks) {
            const bf16x8 av = frag(smem + R_VT, w, ks, fr, fq);
            const bf16x8 ak = frag(smem + R_K, w, ks, fr, fq);
#pragma unroll
            for (int nt = 0; nt < 8; ++nt) {
                kv[nt] = mfma16(av, frag(smem + R_KT, nt, ks, fr, fq), kv[nt]);
                if (nt >= w) sa[nt] = mfma16(ak, frag(smem + R_Q, nt, ks, fr, fq), sa[nt]);
            }
        }
        char* kvb = (char*)((u16*)(p.ws + OFF_KV) + base + w * 2048);
        const unsigned lo = (unsigned)((fq * 4 + odd) * 256 + (fr & ~1) * 2);
#pragma unroll
        for (int nt = 0; nt < 8; ++nt)
#pragma unroll
            for (int rp = 0; rp < 2; ++rp)
                *(uint32_t*)(kvb + (lo + (unsigned)(rp * 512 + nt * 32))) = pair_pack(kv[nt][rp * 2], kv[nt][rp * 2 + 1], odd);
#pragma unroll
        for (int nt = 0; nt < 8; ++nt) {
            const int t = nt * 16 + fr, s0 = w * 16 + fq * 4;
            float o[4];
#pragma unroll
            for (int r = 0; r < 4; ++r) {
                const int s = s0 + r;
                o[r] = (t >= s) ? sa[nt][r] * __expf((float)(t - s) * lg) : 0.f;
            }
            sreg[nt] = pack4(o[0], o[1], o[2], o[3]);
        }
    }
    lds_barrier();
    {
        const int s0 = w * 16 + fq * 4;
#pragma unroll
        for (int nt = 0; nt < 8; ++nt) *(uint2*)(smem + R_KT + swz(nt * 16 + fr, s0 >> 3) + (s0 & 7) * 2) = sreg[nt];
    }
    lds_barrier();
    {
        f32x4 ia[8];
#pragma unroll
        for (int nt = 0; nt < 8; ++nt) ia[nt] = (f32x4){0.f, 0.f, 0.f, 0.f};
#pragma unroll
        for (int ks = 0; ks < 4; ++ks)
            if (ks * 32 <= w * 16 + 15) {
                const bf16x8 af = frag(smem + R_KT, w, ks, fr, fq);
#pragma unroll
                for (int nt = 0; nt < 8; ++nt) ia[nt] = mfma16(af, frag(smem + R_VT, nt, ks, fr, fq), ia[nt]);
            }
        char* igb = (char*)((u16*)(p.ws + OFF_INTRA) + base + w * 2048);
        const unsigned lo = (unsigned)((fq * 4 + odd) * 256 + (fr & ~1) * 2);
#pragma unroll
        for (int nt = 0; nt < 8; ++nt)
#pragma unroll
            for (int rp = 0; rp < 2; ++rp)
                *(uint32_t*)(igb + (lo + (unsigned)(rp * 512 + nt * 32))) = pair_pack(ia[nt][rp * 2], ia[nt][rp * 2 + 1], odd);
    }
    lds_barrier();
}

DEVFN void phase2(const P& p, char* smem, int bid, int nb) {
    for (int it = bid; it < 2048; it += nb) {
        const int chunk = it & 255, i8 = it >> 8, grp = (chunk >> 3) & 1;
        const int j = (i8 >> 1) + (((i8 & 1) ^ grp) << 2);
        if (j < 4) item_gmlp(p, smem, chunk, j);
        else item_ret(p, smem, chunk, j - 4);
    }
}

DEVFN void phase3(const P& p, int bid, int nb) {
    const u16* KV = (const u16*)(p.ws + OFF_KV);
    u16* ST = (u16*)(p.ws + OFF_ST);
    for (int i = bid * NTHREADS + threadIdx.x; i < 262144; i += nb * NTHREADS) {
        const int bh = i >> 12, b = bh >> 2, h = bh & 3, off = (i & 4095) * 4;
        const float lg = __logf(1.0f - exp2f(-5.0f - (float)h));
        const float cd = expf(128.0f * lg);
        uint2 kv[15];
#pragma unroll
        for (int n = 0; n < 15; ++n) kv[n] = *(const uint2*)(KV + (size_t)((b * 16 + n) * 4 + h) * 16384 + off);
        float4 st = make_float4(0.f, 0.f, 0.f, 0.f);
#pragma unroll
        for (int n = 0; n < 16; ++n) {
            *(uint2*)(ST + (size_t)((b * 16 + n) * 4 + h) * 16384 + off) = pack4(st.x, st.y, st.z, st.w);
            if (n < 15) {
                st.x = st.x * cd + bf2f((u16)(kv[n].x & 0xffff)); st.y = st.y * cd + bf2f((u16)(kv[n].x >> 16));
                st.z = st.z * cd + bf2f((u16)(kv[n].y & 0xffff)); st.w = st.w * cd + bf2f((u16)(kv[n].y >> 16));
            }
        }
    }
}

DEVFN void phase45(const P& p, char* smem, int bid, int nb) {
    for (int chunk = bid; chunk < 256; chunk += nb) {
        int tid_ = threadIdx.x; asm volatile("" : "+v"(tid_));
        const int tid = tid_ & 511, lane = tid & 63, w = __builtin_amdgcn_readfirstlane(tid >> 6), fr = lane & 15, fq = lane >> 4;
        const int b = chunk >> 4, odd = fr & 1;
        u16* Yg = (u16*)(p.ws + OFF_Y) + (size_t)chunk * 128 * 1024;
        {
            char* igs = smem + 32768 + w * 13056;
            char* sgs = igs + 4352;
            char* ys = igs + 8704;
            const unsigned so = (unsigned)((tid >> 4) * 256 + (tid & 15) * 16);
            const unsigned wo = (unsigned)((w * 16 + (lane >> 4)) * 256 + (lane & 15) * 16);
            const unsigned qo = (unsigned)((w * 16 + fr) * 256 + fq * 16);
            uint4 stR0, stR1, stR2, stR3, igR0, igR1, igR2, igR3, sgR0, sgR1, sgR2, sgR3;
            bf16x8 qa0, qa1, qa2, qa3;
#define P4_LOADS(HB) { \
                const char* stg = p.ws + OFF_ST + (HB); const char* igg = p.ws + OFF_INTRA + (HB); const char* sgg = p.ws + OFF_SG + (HB); const char* qdg = p.ws + OFF_QD + (HB); \
                stR0 = *(const uint4*)(stg + so); stR1 = *(const uint4*)(stg + (so + 8192u)); stR2 = *(const uint4*)(stg + (so + 16384u)); stR3 = *(const uint4*)(stg + (so + 24576u)); \
                igR0 = *(const uint4*)(igg + wo); igR1 = *(const uint4*)(igg + (wo + 1024u)); igR2 = *(const uint4*)(igg + (wo + 2048u)); igR3 = *(const uint4*)(igg + (wo + 3072u)); \
                sgR0 = *(const uint4*)(sgg + wo); sgR1 = *(const uint4*)(sgg + (wo + 1024u)); sgR2 = *(const uint4*)(sgg + (wo + 2048u)); sgR3 = *(const uint4*)(sgg + (wo + 3072u)); \
                qa0 = *(const bf16x8*)(qdg + qo); qa1 = *(const bf16x8*)(qdg + (qo + 64u)); qa2 = *(const bf16x8*)(qdg + (qo + 128u)); qa3 = *(const bf16x8*)(qdg + (qo + 192u)); }
            P4_LOADS((size_t)(chunk * 4) * 32768)
#pragma unroll
            for (int hh = 0; hh < 4; ++hh) {
                {
                    const int sr = tid >> 4, sc = tid & 15, wr = lane >> 4, wc = (lane & 15) * 16;
                    *(uint4*)(smem + swz(sr, sc)) = stR0; *(uint4*)(smem + swz(sr + 32, sc)) = stR1;
                    *(uint4*)(smem + swz(sr + 64, sc)) = stR2; *(uint4*)(smem + swz(sr + 96, sc)) = stR3;
                    *(uint4*)(igs + wr * 272 + wc) = igR0; *(uint4*)(igs + (wr + 4) * 272 + wc) = igR1;
                    *(uint4*)(igs + (wr + 8) * 272 + wc) = igR2; *(uint4*)(igs + (wr + 12) * 272 + wc) = igR3;
                    *(uint4*)(sgs + wr * 272 + wc) = sgR0; *(uint4*)(sgs + (wr + 4) * 272 + wc) = sgR1;
                    *(uint4*)(sgs + (wr + 8) * 272 + wc) = sgR2; *(uint4*)(sgs + (wr + 12) * 272 + wc) = sgR3;
                }
                lds_barrier();
                bf16x8 qc[4];
                qc[0] = qa0; qc[1] = qa1; qc[2] = qa2; qc[3] = qa3;
                {
                    const int sct = hh * 512 + tid;
                    const float tv = *(const float*)((const char*)Yg + (unsigned)((sct >> 4) * 2048 + (sct & 15) * 64));
                    asm volatile("" :: "v"(tv));
                }
                P4_LOADS((size_t)(chunk * 4 + (hh < 3 ? hh + 1 : 3)) * 32768)
                f32x4 o[8];
#pragma unroll
                for (int nt = 0; nt < 8; ++nt) {
                    o[nt] = (f32x4){0.f, 0.f, 0.f, 0.f};
#pragma unroll
                    for (int ks = 0; ks < 4; ++ks) o[nt] = mfma16(qc[ks], frag(smem, nt, ks, fr, fq), o[nt]);
                }
#pragma unroll
                for (int nt = 0; nt < 8; ++nt)
#pragma unroll
                    for (int r = 0; r < 4; ++r) o[nt][r] += bf2f(*(const u16*)(igs + (fq * 4 + r) * 272 + (nt * 16 + fr) * 2));
                float gng[8];
#pragma unroll
                for (int nt = 0; nt < 8; ++nt) gng[nt] = p.gn_g[hh * 128 + nt * 16 + fr];
#pragma unroll
                for (int rp = 0; rp < 2; ++rp) {
                    float yv[2][8];
#pragma unroll
                    for (int r2 = 0; r2 < 2; ++r2) {
                        const int r = rp * 2 + r2;
                        float s = 0.f;
#pragma unroll
                        for (int nt = 0; nt < 8; ++nt) s += o[nt][r];
                        s = red16(s);
                        const float mean = s * (1.0f / 128.0f);
                        float q2 = 0.f;
#pragma unroll
                        for (int nt = 0; nt < 8; ++nt) { const float dv = o[nt][r] - mean; q2 += dv * dv; }
                        q2 = red16(q2);
                        const float rstd = rsqrtf(q2 * (1.0f / 128.0f) + 1e-6f);
#pragma unroll
                        for (int nt = 0; nt < 8; ++nt) {
                            const float gv = bf2f(*(const u16*)(sgs + (fq * 4 + r) * 272 + (nt * 16 + fr) * 2));
                            yv[r2][nt] = (o[nt][r] - mean) * rstd * gng[nt] * gv;
                        }
                    }
#pragma unroll
                    for (int nt = 0; nt < 8; ++nt)
                        *(uint32_t*)(ys + (fq * 4 + rp * 2 + odd) * 272 + (nt * 16 + (fr & ~1)) * 2) = pair_pack(yv[0][nt], yv[1][nt], odd);
                }
                asm volatile("s_waitcnt lgkmcnt(0)" ::: "memory");
                char* yo = (char*)(Yg + (size_t)(w * 16) * 1024 + 512 + hh * 128);
#pragma unroll
                for (int i = 0; i < 4; ++i) {
                    const int row = (lane >> 4) + 4 * i, ch = lane & 15;
                    *(uint4*)(yo + (unsigned)(row * 2048 + ch * 16)) = *(const uint4*)(ys + row * 272 + ch * 16);
                }
                lds_barrier();
            }
        }
        __threadfence_block();
        __syncthreads();
        float* part = (float*)(smem + SM_SMALL);
        float* rsv = (float*)(smem + 65536);
        f32x4 acc[8][4];
        char* outb = (char*)(p.out + (size_t)chunk * 128 * 1024 + w * 64);
        const char* xb = (const char*)(p.x + (size_t)chunk * 128 * 1024 + w * 64);
        const unsigned oo = (unsigned)(fq * 16384 + fr * 4);
        u16* Zg = (u16*)(p.ws + OFF_Z) + (size_t)chunk * 128 * 512;
#define ROWSQ(HF) \
        _Pragma("unroll") for (int mt = 0; mt < 8; ++mt) \
        _Pragma("unroll") for (int r = 0; r < 4; ++r) { \
            float s = 0.f; \
            _Pragma("unroll") for (int nt = 0; nt < 4; ++nt) s += acc[mt][nt][r] * acc[mt][nt][r]; \
            s = red16(s); \
            if (fr == 0) part[((HF) * 8 + w) * 128 + mt * 16 + fq * 4 + r] = s; \
        }
        {
            const bf16x8* Bf = (const bf16x8*)(p.ws + OFF_WOUTF) + ((size_t)(0 * 8 + w) * 128) * 64;
            gemm_core<4, true>(Yg, Bf, smem, acc, (const char*)(p.x + (size_t)chunk * 128 * 1024));
            ROWSQ(0)
            char* zb = (char*)(Zg + w * 64);
            const unsigned zo = (unsigned)((fq * 4 + odd) * 1024 + (fr & ~1) * 2);
#pragma unroll
            for (int mt = 0; mt < 8; ++mt) {
                char* zm = zb + mt * 16384;
#pragma unroll
                for (int nt = 0; nt < 4; ++nt)
#pragma unroll
                    for (int rp = 0; rp < 2; ++rp)
                        *(uint32_t*)(zm + (zo + (unsigned)(rp * 2048 + nt * 32))) = pair_pack(acc[mt][nt][rp * 2], acc[mt][nt][rp * 2 + 1], odd);
            }
        }
        {
            const bf16x8* Bf = (const bf16x8*)(p.ws + OFF_WOUTF) + ((size_t)(1 * 8 + w) * 128) * 64;
            gemm_core<4>(Yg, Bf, smem, acc);
            ROWSQ(1)
        }
        __syncthreads();
        if (tid < 128) {
            float s = 0.f;
#pragma unroll
            for (int k = 0; k < 16; ++k) s += part[k * 128 + tid];
            rsv[tid] = rsqrtf(s * (1.0f / 1024.0f) + 1e-6f);
        }
        lds_barrier();
        const float* gate = (const float*)(p.ws + OFF_MOD) + b * 3072 + 2048;
        {
            float gg[4];
#pragma unroll
            for (int nt = 0; nt < 4; ++nt) { const int col = 512 + w * 64 + nt * 16 + fr; gg[nt] = gate[col] * p.g_post[col]; }
            const int q = fr & 3, q1 = q & 1, q2 = q >> 1;
            const unsigned po = (unsigned)((fq * 4 + q) * 4096 + (fr & ~3) * 4);
#pragma unroll
            for (int mt = 0; mt < 8; ++mt) {
                float rs4[4];
#pragma unroll
                for (int r = 0; r < 4; ++r) rs4[r] = rsv[mt * 16 + fq * 4 + r];
                char* ob = outb + (mt * 16) * 4096 + 2048;
                const char* xr = xb + (mt * 16) * 4096 + 2048;
#pragma unroll
                for (int nt = 0; nt < 4; ++nt) {
                    float v[4];
#pragma unroll
                    for (int r = 0; r < 4; ++r) v[r] = gg[nt] * acc[mt][nt][r] * rs4[r];
                    const float ra = swap1(q1 ? v[0] : v[1]), rb = swap1(q1 ? v[2] : v[3]);
                    const float a0 = q1 ? ra : v[0], a1 = q1 ? v[1] : ra;
                    const float b0 = q1 ? rb : v[2], b1 = q1 ? v[3] : rb;
                    const float sa = swap2(q2 ? a0 : b0), sb = swap2(q2 ? a1 : b1);
                    float4 o;
                    o.x = q2 ? sa : a0; o.y = q2 ? sb : a1; o.z = q2 ? b0 : sa; o.w = q2 ? b1 : sb;
                    const float4 xv = *(const float4*)(xr + (po + (unsigned)(nt * 64)));
                    o.x += xv.x; o.y += xv.y; o.z += xv.z; o.w += xv.w;
                    *(float4*)(ob + (po + (unsigned)(nt * 64))) = o;
                }
            }
        }
        {
            const int c8 = (tid & 63) * 8, r0 = tid >> 6;
            float gq[8];
            {
                const float4 g0 = *(const float4*)(gate + c8), g1 = *(const float4*)(gate + c8 + 4);
                const float4 p0 = *(const float4*)(p.g_post + c8), p1 = *(const float4*)(p.g_post + c8 + 4);
                gq[0] = g0.x * p0.x; gq[1] = g0.y * p0.y; gq[2] = g0.z * p0.z; gq[3] = g0.w * p0.w;
                gq[4] = g1.x * p1.x; gq[5] = g1.y * p1.y; gq[6] = g1.z * p1.z; gq[7] = g1.w * p1.w;
            }
            char* ob = (char*)(p.out + (size_t)chunk * 128 * 1024);
            const char* xr = (const char*)(p.x + (size_t)chunk * 128 * 1024);
            const char* zr = (const char*)Zg;
            const unsigned vo = (unsigned)(r0 * 4096 + c8 * 4), vz = (unsigned)(r0 * 1024 + c8 * 2);
#pragma unroll 4
            for (int i = 0; i < 16; ++i) {
                const uint4 z = *(const uint4*)(zr + (vz + (unsigned)(i * 8192)));
                const float4 x0 = *(const float4*)(xr + (vo + (unsigned)(i * 32768)));
                const float4 x1 = *(const float4*)(xr + (vo + (unsigned)(i * 32768 + 16)));
                const float rs = rsv[i * 8 + r0];
                float4 o0, o1;
                o0.x = x0.x + gq[0] * bf2f((u16)(z.x & 0xffff)) * rs; o0.y = x0.y + gq[1] * bf2f((u16)(z.x >> 16)) * rs;
                o0.z = x0.z + gq[2] * bf2f((u16)(z.y & 0xffff)) * rs; o0.w = x0.w + gq[3] * bf2f((u16)(z.y >> 16)) * rs;
                o1.x = x1.x + gq[4] * bf2f((u16)(z.z & 0xffff)) * rs; o1.y = x1.y + gq[5] * bf2f((u16)(z.z >> 16)) * rs;
                o1.z = x1.z + gq[6] * bf2f((u16)(z.w & 0xffff)) * rs; o1.w = x1.w + gq[7] * bf2f((u16)(z.w >> 16)) * rs;
                *(float4*)(ob + (vo + (unsigned)(i * 32768))) = o0;
                *(float4*)(ob + (vo + (unsigned)(i * 32768 + 16))) = o1;
            }
        }
        lds_barrier();
    }
}

#ifndef N_LAUNCHES
#define N_LAUNCHES 1
#endif

#if N_LAUNCHES == 1
__global__ void __launch_bounds__(NTHREADS) fwd(P p) {
    __shared__ __attribute__((aligned(16))) char smem[SM_TOTAL];
    const int bid = blockIdx.x, nb = gridDim.x;
    if (threadIdx.x == 0) *(uint4*)(smem + SM_BARW) = make_uint4(0u, 0u, 0u, 0u);
    __syncthreads();
    XcdBarrier xb = xcd_barrier_post((unsigned*)(p.ws + OFF_BAR), (volatile LAS unsigned*)(smem + SM_BARW));
#ifndef REP0
#define REP0 1
#define REP1 1
#define REP2 1
#define REP3 1
#define REP4 1
#endif
#pragma unroll 1
    for (int i = 0; i < REP0; ++i) phase0(p, smem, bid, nb);
    xcd_barrier(xb);
#pragma unroll 1
    for (int i = 0; i < REP1; ++i) phase1(p, bid, nb);
    xcd_barrier(xb);
#pragma unroll 1
    for (int i = 0; i < REP2; ++i) phase2(p, smem, bid, nb);
    xcd_barrier(xb);
#pragma unroll 1
    for (int i = 0; i < REP3; ++i) phase3(p, bid, nb);
    xcd_barrier(xb);
#pragma unroll 1
    for (int i = 0; i < REP4; ++i) phase45(p, smem, bid, nb);
}
#else
__global__ void __launch_bounds__(NTHREADS) k_phase0(P p) { __shared__ __attribute__((aligned(16))) char smem[SM_TOTAL]; phase0(p, smem, blockIdx.x, gridDim.x); }
__global__ void __launch_bounds__(NTHREADS) k_phase1(P p) { phase1(p, blockIdx.x, gridDim.x); }
__global__ void __launch_bounds__(NTHREADS) k_phase2(P p) { __shared__ __attribute__((aligned(16))) char smem[SM_TOTAL]; phase2(p, smem, blockIdx.x, gridDim.x); }
__global__ void __launch_bounds__(NTHREADS) k_phase3(P p) { phase3(p, blockIdx.x, gridDim.x); }
__global__ void __launch_bounds__(NTHREADS) k_phase45(P p) { __shared__ __attribute__((aligned(16))) char smem[SM_TOTAL]; phase45(p, smem, blockIdx.x, gridDim.x); }
#endif

extern "C" void kernel_launch(void* const* d_in, const int* in_sizes, int n_in, void* d_out, int out_size, void* d_ws, size_t ws_size,
                              hipStream_t stream) {
    P p{};
    p.x = (const float*)d_in[0]; p.c = (const float*)d_in[1]; p.pos = (const int*)d_in[2]; p.w_ada = (const float*)d_in[3];
    p.b_ada = (const float*)d_in[4]; p.g_pre = (const float*)d_in[5]; p.w_in = (const float*)d_in[6]; p.ln_g = (const float*)d_in[7];
    p.gws = (const float*)d_in[8]; p.gbs = (const float*)d_in[9]; p.gn_g = (const float*)d_in[10]; p.w_out = (const float*)d_in[11];
    p.g_post = (const float*)d_in[12]; p.out = (float*)d_out; p.ws = (char*)d_ws;
    p.ph_lo = 0; p.ph_hi = 5;
    static int grid = 0;
    if (!grid) { int dev = 0, cus = 0; if (hipGetDevice(&dev) == hipSuccess && hipDeviceGetAttribute(&cus, hipDeviceAttributeMultiprocessorCount, dev) == hipSuccess && cus > 0) grid = cus < 256 ? cus : 256; else grid = 256; }
#if N_LAUNCHES == 1
    (void)hipMemsetAsync((char*)d_ws + OFF_BAR, 0, OFF_MOD + 16 * 3072 * 4, stream);
    void* args[] = {&p};
    hipError_t e = hipLaunchCooperativeKernel((const void*)fwd, dim3(grid), dim3(NTHREADS), args, 0, stream);
    if (e != hipSuccess) fprintf(stderr, "cooperative launch failed: %s\n", hipGetErrorString(e));
#else
    hipLaunchKernelGGL(k_phase0, dim3(grid), dim3(NTHREADS), 0, stream, p);
    hipLaunchKernelGGL(k_phase1, dim3(grid), dim3(NTHREADS), 0, stream, p);
    hipLaunchKernelGGL(k_phase2, dim3(grid), dim3(NTHREADS), 0, stream, p);
    hipLaunchKernelGGL(k_phase3, dim3(grid), dim3(NTHREADS), 0, stream, p);
    hipLaunchKernelGGL(k_phase45, dim3(grid), dim3(NTHREADS), 0, stream, p);
#endif
}
```

```cpp
#include <hip/hip_runtime.h>
#include <stdint.h>
#include <stdio.h>

typedef __attribute__((ext_vector_type(8))) short bf16x8;
typedef __attribute__((ext_vector_type(4))) float f32x4;
typedef unsigned short u16;
#define DEVFN __device__ __forceinline__
#define NTHREADS 512
#define LAS __attribute__((address_space(3)))

#define OFF_BAR    0ull
#define OFF_MOD    65536ull
#define OFF_WINF   262144ull
#define OFF_WOUTF  7602176ull
#define OFF_WS     9699328ull
#define OFF_H      16777216ull
#define OFF_Y      83886080ull
#define OFF_QD     150994944ull
#define OFF_SG     184549376ull
#define OFF_INTRA  218103808ull
#define OFF_KV     285212672ull
#define OFF_ST     OFF_KV
#define OFF_TAB    385875968ull
#define OFF_Z      (OFF_H + 33554432ull)

#define SM_SMALL   139264
#define SM_BARW    147456
#define SM_TOTAL   (147456 + 16)

struct P {
    const float* x; const float* c; const int* pos; const float* w_ada; const float* b_ada; const float* g_pre;
    const float* w_in; const float* ln_g; const float* gws; const float* gbs; const float* gn_g; const float* w_out;
    const float* g_post; float* out; char* ws;
    int ph_lo, ph_hi;
};

typedef __attribute__((ext_vector_type(2))) __bf16 bf2_t;
DEVFN u16 f2bf(float f) { return __builtin_bit_cast(u16, (__bf16)f); }
DEVFN float bf2f(u16 h) { return __uint_as_float(((uint32_t)h) << 16); }
DEVFN uint32_t pack2(float a, float b) { bf2_t v = {(__bf16)a, (__bf16)b}; return __builtin_bit_cast(uint32_t, v); }
DEVFN void lds_barrier() { asm volatile("s_waitcnt lgkmcnt(0)\n\ts_barrier" ::: "memory"); }
DEVFN uint2 pack4(float a, float b, float c, float d) { uint2 r; r.x = pack2(a, b); r.y = pack2(c, d); return r; }
DEVFN float silu(float x) { return x * __builtin_amdgcn_rcpf(1.0f + __expf(-x)); }
template <int CTRL> DEVFN float dppf(float v) { return __int_as_float(__builtin_amdgcn_update_dpp(0, __float_as_int(v), CTRL, 0xF, 0xF, true)); }
DEVFN float red16(float v) { v += dppf<0x128>(v); v += dppf<0x124>(v); v += dppf<0x4E>(v); v += dppf<0xB1>(v); return v; }
DEVFN float red4(float v) { v += dppf<0x4E>(v); v += dppf<0xB1>(v); return v; }
DEVFN float swap2(float v) { return dppf<0x4E>(v); }
DEVFN float swap1(float v) { return __int_as_float(__builtin_amdgcn_update_dpp(0, __float_as_int(v), 0xB1, 0xF, 0xF, true)); }
DEVFN uint32_t pair_pack(float a, float b, int odd) {
    const float recv = swap1(odd ? a : b);
    return odd ? pack2(recv, b) : pack2(a, recv);
}
DEVFN int swz(int row, int chunk) { return row * 256 + ((chunk ^ (row & 15)) << 4); }
DEVFN bf16x8 frag(const char* base, int tile, int ks, int fr, int fq) {
    return *(const bf16x8*)(base + swz(tile * 16 + fr, ks * 4 + fq));
}
DEVFN f32x4 mfma16(bf16x8 a, bf16x8 b, f32x4 c) { return __builtin_amdgcn_mfma_f32_16x16x32_bf16(a, b, c, 0, 0, 0); }

#define XB_TMO      128
#define XB_XCNT(j)  (256  + 64 * (j))
#define XB_XSUB(j)  (1280 + 64 * (j))
#define XB_XGEN(j)  (2304 + 64 * (j))
#define XB_TOP      3328
#define XB_TOPGEN   3392
#define XCD_BAR_WORDS 3456
#define XB_SPIN_CAP (1u << 22)
DEVFN unsigned xb_ld(unsigned* p) { return __hip_atomic_load(p, __ATOMIC_RELAXED, __HIP_MEMORY_SCOPE_AGENT); }
DEVFN unsigned xb_add(unsigned* p, unsigned v) { return __hip_atomic_fetch_add(p, v, __ATOMIC_RELAXED, __HIP_MEMORY_SCOPE_AGENT); }
DEVFN unsigned xb_xcc_id() { return (unsigned)__builtin_amdgcn_s_getreg((3 << 11) | 20) & 0xFu; }
#define XB_SPIN(cond, bar) do { unsigned _sp = 0; while (cond) { __builtin_amdgcn_s_sleep(1); \
    if ((++_sp & 255u) == 0u) { if (xb_ld(&(bar)[XB_TMO])) break; if (_sp > XB_SPIN_CAP) { atomicAdd(&(bar)[XB_TMO], 1u); break; } } } } while (0)
struct XcdBarrier { unsigned* bar; unsigned x; volatile LAS unsigned* st; unsigned G; };
DEVFN XcdBarrier xcd_barrier_post(unsigned* bar, volatile LAS unsigned* st, unsigned G) {
    XcdBarrier b; b.bar = bar; b.x = xb_xcc_id(); b.st = st; b.G = G;
    if (threadIdx.x == 0) (void)xb_add(&bar[XB_XCNT(b.x)], 1u);
    return b;
}
DEVFN void xcd_barrier_complete(unsigned* bar, unsigned x, const unsigned G, unsigned& nloc, unsigned& nx) {
    unsigned sum, cnt, mine, sp = 0u;
    for (;;) {
        sum = 0u; cnt = 0u; mine = 0u;
#pragma unroll
        for (unsigned j = 0; j < 16; ++j) { const unsigned c = xb_ld(&bar[XB_XCNT(j)]); sum += c; cnt += (c > 0u) ? 1u : 0u; mine = (j == x) ? c : mine; }
        if (sum == G) break;
        __builtin_amdgcn_s_sleep(1);
        if ((++sp & 255u) == 0u) { if (xb_ld(&bar[XB_TMO])) break; if (sp > XB_SPIN_CAP) { atomicAdd(&bar[XB_TMO], 1u); break; } }
    }
    nloc = mine > 0u ? mine : 1u; nx = cnt > 0u ? cnt : 1u;
}
DEVFN void xcd_barrier(const XcdBarrier& b) {
    asm volatile("s_waitcnt vmcnt(0)" ::: "memory");
    __syncthreads();
    if (threadIdx.x == 0) {
        unsigned* bar = b.bar;
        __builtin_amdgcn_s_waitcnt(0);
        unsigned nloc = b.st[0], nx = b.st[1];
        if (nloc == 0u) { xcd_barrier_complete(bar, b.x, b.G, nloc, nx); b.st[0] = nloc; b.st[1] = nx; }
        const unsigned old = xb_add(&bar[XB_XSUB(b.x)], 1u);
        const unsigned gen = old / nloc;
        if (old + 1u == (gen + 1u) * nloc) {
            __builtin_amdgcn_fence(__ATOMIC_RELEASE, "agent");
            asm volatile("s_waitcnt vmcnt(0)" ::: "memory");
            const unsigned og = xb_add(&bar[XB_TOP], 1u);
            const unsigned tg = og / nx;
            if (og + 1u == (tg + 1u) * nx) xb_add(&bar[XB_TOPGEN], 1u);
            else XB_SPIN(xb_ld(&bar[XB_TOPGEN]) == tg, bar);
            __builtin_amdgcn_fence(__ATOMIC_ACQUIRE, "agent");
            xb_add(&bar[XB_XGEN(b.x)], 1u);
            asm volatile("s_waitcnt vmcnt(0)" ::: "memory");
        } else {
            XB_SPIN(xb_ld(&bar[XB_XGEN(b.x)]) == gen, bar);
            __builtin_amdgcn_fence(__ATOMIC_ACQUIRE, "agent");
            asm volatile("s_waitcnt vmcnt(0)" ::: "memory");
        }
    }
    __syncthreads();
}

DEVFN int proj_feature(int j, int w, int nt, int c) {
    if (j < 4) return nt * 512 + j * 128 + w * 16 + c;
    const int hh = j - 4;
    if (nt < 2) return (c < 8 ? 1536 : 2048) + hh * 128 + nt * 64 + w * 8 + (c & 7);
    if (nt == 2) return 2560 + hh * 128 + w * 16 + c;
    return 3072 + hh * 128 + w * 16 + c;
}

DEVFN void phase0(const P& p, char* smem, int bid, int nb) {
    const int tid = threadIdx.x, lane = tid & 63, w = __builtin_amdgcn_readfirstlane(tid >> 6);
    const int N_MOD = 768, N_WIN = 0, N_WOUT = 0, N_WS = 16;
    const int NITEMS = N_MOD + N_WIN + N_WOUT + N_WS;
    for (int it = bid; it < NITEMS; it += nb) {
        if (it < N_MOD) {
            float* sc = (float*)smem;
            float* red = (float*)(smem + 65536);
            const int cg = it >> 3, ksp = it & 7, e0 = cg * 32, d0 = ksp * 128;
            lds_barrier();
            for (int i = tid; i < 2048; i += NTHREADS) sc[i] = silu(p.c[(i >> 7) * 1024 + d0 + (i & 127)]);
            lds_barrier();
            const int col = tid & 31, kg = tid >> 5;
            float wv[8];
#pragma unroll
            for (int q = 0; q < 8; ++q) wv[q] = p.w_ada[(size_t)(d0 + kg * 8 + q) * 3072 + e0 + col];
            float acc[16];
#pragma unroll
            for (int b = 0; b < 16; ++b) {
                float a = 0.f;
#pragma unroll
                for (int q = 0; q < 8; ++q) a += sc[b * 128 + kg * 8 + q] * wv[q];
                acc[b] = a;
            }
#pragma unroll
            for (int b = 0; b < 16; ++b) red[(kg * 16 + b) * 32 + col] = acc[b];
            lds_barrier();
            {
                const int b = tid >> 5;
                float s = (ksp == 0) ? p.b_ada[e0 + col] : 0.f;
#pragma unroll
                for (int k = 0; k < 16; ++k) s += red[(k * 16 + b) * 32 + col];
                atomicAdd((float*)(p.ws + OFF_MOD) + b * 3072 + e0 + col, s);
            }
        } else {
            const int base = (it - N_MOD - N_WIN - N_WOUT) * 4096 + tid * 8;
            const int t = (base >> 7) & 127, s0 = base & 127;
            float v[8];
#pragma unroll
            for (int q = 0; q < 8; ++q) v[q] = (s0 + q <= t) ? p.gws[base + q] : 0.f;
            uint4 o; o.x = pack2(v[0], v[1]); o.y = pack2(v[2], v[3]); o.z = pack2(v[4], v[5]); o.w = pack2(v[6], v[7]);
            *(uint4*)((u16*)(p.ws + OFF_WS) + base) = o;
        }
    }
}

DEVFN void phase0_conv(const P& p, int bid, int nb) {
    const int tid = threadIdx.x, lane = tid & 63, w = __builtin_amdgcn_readfirstlane(tid >> 6);
    {
        const int TW = nb * 8, gw = bid * 8 + w;
#pragma unroll 1
        for (int f0 = gw; f0 < 9216; f0 += 4 * TW) {
            float v[4][8];
            const float* srcp[4]; int strd[4];
#pragma unroll
            for (int u = 0; u < 4; ++u) {
                const int F = f0 + u * TW;
                const int k0 = (lane >> 4) * 8;
                if (F < 7168) {
                    int j, ww, ks, nt;
                    if (F < 3072) { j = F / 768; int rem = F % 768; ww = rem / 96; int r2 = rem % 96; ks = r2 / 3; nt = r2 % 3; }
                    else { int f2 = F - 3072; j = 4 + f2 / 1024; int rem = f2 % 1024; ww = rem / 128; int r2 = rem % 128; ks = r2 / 4; nt = r2 % 4; }
                    srcp[u] = p.w_in + (size_t)(ks * 32 + k0) * 3584 + proj_feature(j, ww, nt, lane & 15); strd[u] = 3584;
                } else {
                    const int G = (F < 9216 ? F : 9215) - 7168;
                    const int nt = G & 3, ks = (G >> 2) & 31, hw = G >> 7;
                    srcp[u] = p.w_out + (size_t)(ks * 32 + k0) * 1024 + hw * 64 + nt * 16 + (lane & 15); strd[u] = 1024;
                }
            }
#pragma unroll
            for (int u = 0; u < 4; ++u)
#pragma unroll
                for (int q = 0; q < 8; ++q) v[u][q] = srcp[u][(size_t)q * strd[u]];
#pragma unroll
            for (int u = 0; u < 4; ++u) {
                const int F = f0 + u * TW;
                uint4 o; o.x = pack2(v[u][0], v[u][1]); o.y = pack2(v[u][2], v[u][3]); o.z = pack2(v[u][4], v[u][5]); o.w = pack2(v[u][6], v[u][7]);
                if (F < 7168) ((uint4*)(p.ws + OFF_WINF))[(size_t)F * 64 + lane] = o;
                else if (F < 9216) ((uint4*)(p.ws + OFF_WOUTF))[(size_t)(F - 7168) * 64 + lane] = o;
            }
        }
    }
}

DEVFN void phase1(const P& p, int bid, int nb) {
    const int tid = threadIdx.x, lane = tid & 63, w = __builtin_amdgcn_readfirstlane(tid >> 6);
    const float* mod = (const float*)(p.ws + OFF_MOD);
    u16* H = (u16*)(p.ws + OFF_H);
    for (int rg = bid * 8 + w; rg < 2048; rg += nb * 8) {
        const int b = rg >> 7;

        float gs[16], sh[16];
#pragma unroll
        for (int i = 0; i < 4; ++i) {
            const int col = (i * 64 + lane) * 4;
            const float4 g = *(const float4*)(p.g_pre + col);
            const float4 s = *(const float4*)(mod + b * 3072 + 1024 + col);
            const float4 t = *(const float4*)(mod + b * 3072 + col);
            gs[i * 4 + 0] = g.x * (1.f + s.x); gs[i * 4 + 1] = g.y * (1.f + s.y); gs[i * 4 + 2] = g.z * (1.f + s.z); gs[i * 4 + 3] = g.w * (1.f + s.w);
            sh[i * 4 + 0] = t.x; sh[i * 4 + 1] = t.y; sh[i * 4 + 2] = t.z; sh[i * 4 + 3] = t.w;
        }
#pragma unroll 4
        for (int r = 0; r < 16; ++r) {
            const size_t row = (size_t)rg * 16 + r;
            const float4* xr = (const float4*)(p.x + row * 1024);
            float4 v[4];
#pragma unroll
            for (int i = 0; i < 4; ++i) v[i] = xr[i * 64 + lane];
            float ss = 0.f;
#pragma unroll
            for (int i = 0; i < 4; ++i) ss += v[i].x * v[i].x + v[i].y * v[i].y + v[i].z * v[i].z + v[i].w * v[i].w;
            ss = red16(ss); ss += __shfl_xor(ss, 16); ss += __shfl_xor(ss, 32);
            const float rs = rsqrtf(ss * (1.0f / 1024.0f) + 1e-6f);
#pragma unroll
            for (int i = 0; i < 4; ++i) {
                const uint2 o = pack4(v[i].x * rs * gs[i * 4 + 0] + sh[i * 4 + 0], v[i].y * rs * gs[i * 4 + 1] + sh[i * 4 + 1],
                                      v[i].z * rs * gs[i * 4 + 2] + sh[i * 4 + 2], v[i].w * rs * gs[i * 4 + 3] + sh[i * 4 + 3]);
                *(uint2*)(H + row * 1024 + (i * 64 + lane) * 4) = o;
            }
        }
    }
}

template <int NT>
DEVFN void gemm_step(const char* An, const char* Bn, const unsigned avo, const unsigned bvo, char* smem, const int cur, const int aw,
                     const int foff0, const int foff1, f32x4 (&acc)[8][NT], const bf16x8 (&bc)[2][NT], bf16x8 (&bn)[2][NT],
                     const uint4& w0, const uint4& w1, uint4& l0, uint4& l1) {
    {
        bf16x8 x0 = *(const bf16x8*)(smem + cur + foff0), x1 = *(const bf16x8*)(smem + cur + 2048 + foff0);
#pragma unroll
        for (int g = 0; g < 8; ++g) {
            const int ss = g >> 2, m0 = (g & 3) * 2;
            bf16x8 y0 = x0, y1 = x1;
            if (g < 7) {
                const int gn = g + 1, fo = (gn >> 2) ? foff1 : foff0, mn = (gn & 3) * 2;
                y0 = *(const bf16x8*)(smem + cur + mn * 2048 + fo);
                y1 = *(const bf16x8*)(smem + cur + (mn + 1) * 2048 + fo);
            }
            if (g == 0) l0 = *(const uint4*)(An + avo);
            if (g == 1) l1 = *(const uint4*)(An + (avo + 131072u));
            if (g < 2 * NT) bn[g / NT][g % NT] = *(const bf16x8*)(Bn + (bvo + (unsigned)(g * 1024)));
            __builtin_amdgcn_sched_barrier(0);
#pragma unroll
            for (int nt = 0; nt < NT; ++nt) {
                acc[m0][nt] = mfma16(x0, bc[ss][nt], acc[m0][nt]);
                acc[m0 + 1][nt] = mfma16(x1, bc[ss][nt], acc[m0 + 1][nt]);
            }
            x0 = y0; x1 = y1;
        }
    }
    __builtin_amdgcn_sched_barrier(0);
    *(uint4*)(smem + (cur ^ 16384) + aw) = w0;
    *(uint4*)(smem + (cur ^ 16384) + aw + 8192) = w1;
    lds_barrier();
}

template <int NT, bool PF = false>
DEVFN void gemm_core(const u16* __restrict__ A, const bf16x8* __restrict__ Bf, char* smem, f32x4 (&acc)[8][NT], const char* pf = nullptr) {
    int tid_ = threadIdx.x; asm volatile("" : "+v"(tid_));
    const int tid = tid_ & 511, lane = tid & 63;
    const int fr = lane & 15, fq = lane >> 4;
    const int ar = tid >> 3, ac = tid & 7;
    const char* Ab = (const char*)A;
    const char* Bb = (const char*)Bf;
    const unsigned avo = (unsigned)(ar * 2048 + ac * 16);
    const unsigned bvo = (unsigned)(lane * 16);
    const int aw = ar * 128 + ((ac ^ (ar & 7)) << 4);
    const int foff0 = fr * 128 + (((0 + fq) ^ (fr & 7)) << 4);
    const int foff1 = fr * 128 + (((4 + fq) ^ (fr & 7)) << 4);
#pragma unroll
    for (int mt = 0; mt < 8; ++mt)
#pragma unroll
        for (int nt = 0; nt < NT; ++nt) acc[mt][nt] = (f32x4){0.f, 0.f, 0.f, 0.f};
    uint4 ra0, ra1, rb0, rb1;
    {
        const uint4 a0 = *(const uint4*)(Ab + avo), a1 = *(const uint4*)(Ab + (avo + 131072u));
        rb0 = *(const uint4*)(Ab + 128 + avo); rb1 = *(const uint4*)(Ab + 128 + (avo + 131072u));
        *(uint4*)(smem + aw) = a0;
        *(uint4*)(smem + aw + 8192) = a1;
    }
    bf16x8 b0[2][NT], b1[2][NT];
#pragma unroll
    for (int ss = 0; ss < 2; ++ss)
#pragma unroll
        for (int nt = 0; nt < NT; ++nt) b0[ss][nt] = *(const bf16x8*)(Bb + (bvo + (unsigned)((ss * NT + nt) * 1024)));
    lds_barrier();
    const unsigned pfo = (unsigned)(((tid >> 6) * 64 + lane) * 64);
    float pfv = 0.f;
#pragma unroll 1
    for (int k2 = 0; k2 < 8; ++k2) {
        if (PF) {
            asm volatile("" :: "v"(pfv));
            const float t0 = *(const float*)(pf + (pfo + (unsigned)(k2 * 65536)));
            const float t1 = *(const float*)(pf + (pfo + (unsigned)(k2 * 65536 + 32768)));
            pfv = t0 + t1;
        }
        const int n1 = 2 * k2 + 1;
        const int n2 = k2 < 7 ? 2 * k2 + 2 : 15;
        const int n3 = k2 < 7 ? 2 * k2 + 3 : 15;
        gemm_step<NT>(Ab + n2 * 128, Bb + n1 * (2 * NT * 1024), avo, bvo, smem, 0, aw, foff0, foff1, acc, b0, b1, rb0, rb1, ra0, ra1);
        gemm_step<NT>(Ab + n3 * 128, Bb + n2 * (2 * NT * 1024), avo, bvo, smem, 16384, aw, foff0, foff1, acc, b1, b0, ra0, ra1, rb0, rb1);
    }
    if (PF) asm volatile("" :: "v"(pfv));
}

#define G_VS   0
#define G_VLT  69632
#define G_WS   102400
#define G_Y    0
DEVFN void item_gmlp(const P& p, char* smem, int chunk, int g) {
    int tid_ = threadIdx.x; asm volatile("" : "+v"(tid_)); const int tid = tid_ & 511, lane = tid & 63, w = __builtin_amdgcn_readfirstlane(tid >> 6), fr = lane & 15, fq = lane >> 4;
    float* stats = (float*)(smem + SM_SMALL);
    float* bsv = (float*)(smem + SM_SMALL + 1024);
    if (tid < 128) bsv[tid] = p.gbs[g * 128 + tid];
    f32x4 acc[8][3];
    const u16* A = (const u16*)(p.ws + OFF_H) + (size_t)chunk * 128 * 1024;
    const bf16x8* Bf = (const bf16x8*)(p.ws + OFF_WINF) + ((size_t)g * 768 + w * 96) * 64;
    gemm_core<3>(A, Bf, smem, acc);
    const int d = w * 16 + fr;
    {
        float* VS = (float*)(smem + G_VS);
#pragma unroll
        for (int mt = 0; mt < 8; ++mt)
#pragma unroll
            for (int r = 0; r < 4; ++r) VS[(mt * 16 + fq * 4 + r) * 132 + d] = acc[mt][1][r];
        const uint4* wsg = (const uint4*)((const u16*)(p.ws + OFF_WS) + g * 16384);
#pragma unroll
        for (int i = 0; i < 4; ++i) {
            const int row = (tid >> 4) + 32 * i, ch = tid & 15;
            *(uint4*)(smem + G_WS + swz(row, ch)) = wsg[row * 16 + ch];
        }
    }
    lds_barrier();
    {
        const float* VS = (const float*)(smem + G_VS);
        const int row = tid >> 2, q = tid & 3;
        float v[32];
#pragma unroll
        for (int i = 0; i < 8; ++i) {
            const float4 t4 = *(const float4*)(VS + row * 132 + q * 32 + i * 4);
            v[i * 4 + 0] = t4.x; v[i * 4 + 1] = t4.y; v[i * 4 + 2] = t4.z; v[i * 4 + 3] = t4.w;
        }
        float s = 0.f;
#pragma unroll
        for (int i = 0; i < 32; ++i) s += v[i];
        s = red4(s);
        const float mean = s * (1.0f / 128.0f);
        float q2 = 0.f;
#pragma unroll
        for (int i = 0; i < 32; ++i) { const float dv = v[i] - mean; q2 += dv * dv; }
        q2 = red4(q2);
        if (q == 0) { stats[row * 2] = mean; stats[row * 2 + 1] = rsqrtf(q2 * (1.0f / 128.0f) + 1e-6f); }
    }
    lds_barrier();
    {
        const float lg = p.ln_g[g * 128 + d];
#pragma unroll
        for (int mt = 0; mt < 8; ++mt) {
            const int s0 = mt * 16 + fq * 4;
            float o[4];
#pragma unroll
            for (int r = 0; r < 4; ++r) {
                const float2 st = *(const float2*)(stats + (s0 + r) * 2);
                o[r] = (acc[mt][1][r] - st.x) * st.y * lg;
            }
            *(uint2*)(smem + G_VLT + swz(d, s0 >> 3) + (s0 & 7) * 2) = pack4(o[0], o[1], o[2], o[3]);
        }
    }
    lds_barrier();
    {
        bf16x8 bv[4];
#pragma unroll
        for (int ks = 0; ks < 4; ++ks) bv[ks] = frag(smem + G_VLT, w, ks, fr, fq);
#pragma unroll
        for (int mt = 0; mt < 8; ++mt) {
            f32x4 m = (f32x4){0.f, 0.f, 0.f, 0.f};
#pragma unroll
            for (int ks = 0; ks < 4; ++ks)
                if (ks * 32 <= mt * 16 + 15) m = mfma16(frag(smem + G_WS, mt, ks, fr, fq), bv[ks], m);
#pragma unroll
            for (int r = 0; r < 4; ++r) {
                const int t = mt * 16 + fq * 4 + r;
                const float o = acc[mt][0][r] * (m[r] + bsv[t]) * silu(acc[mt][2][r]);
                *(u16*)(smem + G_Y + t * 272 + d * 2) = f2bf(o);
            }
        }
    }
    lds_barrier();
    {
        u16* Y = (u16*)(p.ws + OFF_Y) + (size_t)chunk * 128 * 1024 + g * 128;
#pragma unroll
        for (int i = 0; i < 4; ++i) {
            const int row = (tid >> 4) + 32 * i, ch = tid & 15;
            *(uint4*)(Y + (size_t)row * 1024 + ch * 8) = *(const uint4*)(smem + G_Y + row * 272 + ch * 16);
        }
    }
    lds_barrier();
}

#define R_Q   0
#define R_K   32768
#define R_KT  65536
#define R_VT  98304
DEVFN void item_ret(const P& p, char* smem, int chunk, int hh) {
    int tid_ = threadIdx.x; asm volatile("" : "+v"(tid_)); const int tid = tid_ & 511, lane = tid & 63, w = __builtin_amdgcn_readfirstlane(tid >> 6), fr = lane & 15, fq = lane >> 4;
    float* posf = (float*)(smem + SM_SMALL);
    float* kdec = posf + 128;
    float* qdec = posf + 256;
    const float lg = __logf(1.0f - exp2f(-5.0f - (float)hh));
    if (tid < 128) {
        posf[tid] = (float)p.pos[chunk * 128 + tid];
        kdec[tid] = expf((float)(127 - tid) * lg);
        qdec[tid] = expf((float)(tid + 1) * lg);
    }
    f32x4 acc[8][4];
    const u16* A = (const u16*)(p.ws + OFF_H) + (size_t)chunk * 128 * 1024;
    const bf16x8* Bf = (const bf16x8*)(p.ws + OFF_WINF) + ((size_t)3072 + hh * 1024 + w * 128) * 64;
    gemm_core<4>(A, Bf, smem, acc);
    const size_t base = (size_t)(chunk * 4 + hh) * 16384;
    const int odd = fr & 1;
    {
        const int isk = fr >> 3, d = w * 8 + (fr & 7), de = d & ~1;
        const float scale = isk ? 0.08838834764831845f : 1.0f;
        const float invf = 1.0f / powf(10000.0f, (float)d * (1.0f / 64.0f));
        char* RX = smem + (isk ? R_K : R_Q);
        const int e = w * 16 + fr;
        char* sgb = (char*)((u16*)(p.ws + OFF_SG) + base + w * 16);
        const unsigned lo = (unsigned)((fq * 4 + odd) * 256 + (fr & ~1) * 2);
#pragma unroll
        for (int mt = 0; mt < 8; ++mt) {
            const int t0 = mt * 16 + fq * 4;
            float r1[4], r2[4];
#pragma unroll
            for (int r = 0; r < 4; ++r) {
                const float rev = (posf[t0 + r] * invf) * 0.15915494309189535f;
                const float frv = rev - floorf(rev);
                const float cs = __builtin_amdgcn_cosf(frv) * scale, sn = __builtin_amdgcn_sinf(frv) * scale;
                const float x1 = acc[mt][0][r], x2 = acc[mt][1][r];
                r1[r] = x1 * cs - x2 * sn; r2[r] = x2 * cs + x1 * sn;
            }
            if (isk) {
                const float4 kd = *(const float4*)(kdec + t0);
                *(uint2*)(smem + R_KT + swz(d, t0 >> 3) + (t0 & 7) * 2) = pack4(r1[0] * kd.x, r1[1] * kd.y, r1[2] * kd.z, r1[3] * kd.w);
                *(uint2*)(smem + R_KT + swz(d + 64, t0 >> 3) + (t0 & 7) * 2) = pack4(r2[0] * kd.x, r2[1] * kd.y, r2[2] * kd.z, r2[3] * kd.w);
            }
#pragma unroll
            for (int rp = 0; rp < 2; ++rp) {
                const int tr = t0 + rp * 2 + odd;
                *(uint32_t*)(RX + swz(tr, de >> 3) + (de & 7) * 2) = pair_pack(r1[rp * 2], r1[rp * 2 + 1], odd);
                *(uint32_t*)(RX + swz(tr, (de + 64) >> 3) + (de & 7) * 2) = pair_pack(r2[rp * 2], r2[rp * 2 + 1], odd);
            }
            *(uint2*)(smem + R_VT + swz(e, t0 >> 3) + (t0 & 7) * 2) = pack4(acc[mt][2][0], acc[mt][2][1], acc[mt][2][2], acc[mt][2][3]);
#pragma unroll
            for (int rp = 0; rp < 2; ++rp)
                *(uint32_t*)(sgb + (lo + (unsigned)(mt * 4096 + rp * 512))) = pair_pack(silu(acc[mt][3][rp * 2]), silu(acc[mt][3][rp * 2 + 1]), odd);
        }
    }
    lds_barrier();
    uint2 sreg[8];
    {
        u16* qd = (u16*)(p.ws + OFF_QD) + base;
#pragma unroll
        for (int i = 0; i < 4; ++i) {
            const int row = (tid >> 4) + 32 * i, ch = tid & 15;
            const uint4 v = *(const uint4*)(smem + R_Q + swz(row, ch));
            const float f = qdec[row];
            uint4 o;
            o.x = pack2(bf2f((u16)(v.x & 0xffff)) * f, bf2f((u16)(v.x >> 16)) * f);
            o.y = pack2(bf2f((u16)(v.y & 0xffff)) * f, bf2f((u16)(v.y >> 16)) * f);
            o.z = pack2(bf2f((u16)(v.z & 0xffff)) * f, bf2f((u16)(v.z >> 16)) * f);
            o.w = pack2(bf2f((u16)(v.w & 0xffff)) * f, bf2f((u16)(v.w >> 16)) * f);
            *(uint4*)(qd + row * 128 + ch * 8) = o;
        }
        f32x4 kv[8], sa[8];
#pragma unroll
        for (int nt = 0; nt < 8; ++nt) { kv[nt] = (f32x4){0.f, 0.f, 0.f, 0.f}; sa[nt] = (f32x4){0.f, 0.f, 0.f, 0.f}; }
#pragma unroll
        for (int ks = 0; ks < 4; ++ks) {
            const bf16x8 av = frag(smem + R_VT, w, ks, fr, fq);
            const bf16x8 ak = frag(smem + R_K, w, ks, fr, fq);
#pragma unroll
            for (int nt = 0; nt < 8; ++nt) {
                kv[nt] = mfma16(av, frag(smem + R_KT, nt, ks, fr, fq), kv[nt]);
                if (nt >= w) sa[nt] = mfma16(ak, frag(smem + R_Q, nt, ks, fr, fq), sa[nt]);
            }
        }
        char* kvb = (char*)((u16*)(p.ws + OFF_KV) + base + w * 2048);
        const unsigned lo = (unsigned)((fq * 4 + odd) * 256 + (fr & ~1) * 2);
#pragma unroll
        for (int nt = 0; nt < 8; ++nt)
#pragma unroll
            for (int rp = 0; rp < 2; ++rp)
                *(uint32_t*)(kvb + (lo + (unsigned)(rp * 512 + nt * 32))) = pair_pack(kv[nt][rp * 2], kv[nt][rp * 2 + 1], odd);
#pragma unroll
        for (int nt = 0; nt < 8; ++nt) {
            const int t = nt * 16 + fr, s0 = w * 16 + fq * 4;
            float o[4];
#pragma unroll
            for (int r = 0; r < 4; ++r) {
                const int s = s0 + r;
                o[r] = (t >= s) ? sa[nt][r] * __expf((float)(t - s) * lg) : 0.f;
            }
            sreg[nt] = pack4(o[0], o[1], o[2], o[3]);
        }
    }
    lds_barrier();
    {
        const int s0 = w * 16 + fq * 4;
#pragma unroll
        for (int nt = 0; nt < 8; ++nt) *(uint2*)(smem + R_KT + swz(nt * 16 + fr, s0 >> 3) + (s0 & 7) * 2) = sreg[nt];
    }
    lds_barrier();
    {
        f32x4 ia[8];
#pragma unroll
        for (int nt = 0; nt < 8; ++nt) ia[nt] = (f32x4){0.f, 0.f, 0.f, 0.f};
#pragma unroll
        for (int ks = 0; ks < 4; ++ks)
            if (ks * 32 <= w * 16 + 15) {
                const bf16x8 af = frag(smem + R_KT, w, ks, fr, fq);
#pragma unroll
                for (int nt = 0; nt < 8; ++nt) ia[nt] = mfma16(af, frag(smem + R_VT, nt, ks, fr, fq), ia[nt]);
            }
        char* igb = (char*)((u16*)(p.ws + OFF_INTRA) + base + w * 2048);
        const unsigned lo = (unsigned)((fq * 4 + odd) * 256 + (fr & ~1) * 2);
#pragma unroll
        for (int nt = 0; nt < 8; ++nt)
#pragma unroll
            for (int rp = 0; rp < 2; ++rp)
                *(uint32_t*)(igb + (lo + (unsigned)(rp * 512 + nt * 32))) = pair_pack(ia[nt][rp * 2], ia[nt][rp * 2 + 1], odd);
    }
    lds_barrier();
}

DEVFN void phase2(const P& p, char* smem, int bid, int nb) {
    for (int it = bid; it < 2048; it += nb) {
        const int chunk = it & 255, i8 = it >> 8, grp = (chunk >> 3) & 1;
        const int j = (i8 >> 1) + (((i8 & 1) ^ grp) << 2);
        if (j < 4) item_gmlp(p, smem, chunk, j);
        else item_ret(p, smem, chunk, j - 4);
    }
}

DEVFN void phase3(const P& p, int bid, int nb, const int bh0 = 0, const int nbh = 64) {
    const u16* KV = (const u16*)(p.ws + OFF_KV);
    u16* ST = (u16*)(p.ws + OFF_ST);
    for (int i = bid * NTHREADS + threadIdx.x; i < nbh * 4096; i += nb * NTHREADS) {
        const int bh = bh0 + (i >> 12), b = bh >> 2, h = bh & 3, off = (i & 4095) * 4;
        const float lg = __logf(1.0f - exp2f(-5.0f - (float)h));
        const float cd = expf(128.0f * lg);
        uint2 kv[15];
#pragma unroll
        for (int n = 0; n < 15; ++n) kv[n] = *(const uint2*)(KV + (size_t)((b * 16 + n) * 4 + h) * 16384 + off);
        float4 st = make_float4(0.f, 0.f, 0.f, 0.f);
#pragma unroll
        for (int n = 0; n < 16; ++n) {
            *(uint2*)(ST + (size_t)((b * 16 + n) * 4 + h) * 16384 + off) = pack4(st.x, st.y, st.z, st.w);
            if (n < 15) {
                st.x = st.x * cd + bf2f((u16)(kv[n].x & 0xffff)); st.y = st.y * cd + bf2f((u16)(kv[n].x >> 16));
                st.z = st.z * cd + bf2f((u16)(kv[n].y & 0xffff)); st.w = st.w * cd + bf2f((u16)(kv[n].y >> 16));
            }
        }
    }
}

DEVFN void phase45(const P& p, char* smem, int bid, int nb) {
    for (int chunk = bid; chunk < 256; chunk += nb) {
        int tid_ = threadIdx.x; asm volatile("" : "+v"(tid_));
        const int tid = tid_ & 511, lane = tid & 63, w = __builtin_amdgcn_readfirstlane(tid >> 6), fr = lane & 15, fq = lane >> 4;
        const int b = chunk >> 4, odd = fr & 1;
        u16* Yg = (u16*)(p.ws + OFF_Y) + (size_t)chunk * 128 * 1024;
        {
            char* igs = smem + 32768 + w * 13056;
            char* sgs = igs + 4352;
            char* ys = igs + 8704;
            const unsigned so = (unsigned)((tid >> 4) * 256 + (tid & 15) * 16);
            const unsigned wo = (unsigned)((w * 16 + (lane >> 4)) * 256 + (lane & 15) * 16);
            const unsigned qo = (unsigned)((w * 16 + fr) * 256 + fq * 16);
            uint4 stR0, stR1, stR2, stR3, igR0, igR1, igR2, igR3, sgR0, sgR1, sgR2, sgR3;
            bf16x8 qa0, qa1, qa2, qa3;
#define P4_LOADS(HB) { \
                const char* stg = p.ws + OFF_ST + (HB); const char* igg = p.ws + OFF_INTRA + (HB); const char* sgg = p.ws + OFF_SG + (HB); const char* qdg = p.ws + OFF_QD + (HB); \
                stR0 = *(const uint4*)(stg + so); stR1 = *(const uint4*)(stg + (so + 8192u)); stR2 = *(const uint4*)(stg + (so + 16384u)); stR3 = *(const uint4*)(stg + (so + 24576u)); \
                igR0 = *(const uint4*)(igg + wo); igR1 = *(const uint4*)(igg + (wo + 1024u)); igR2 = *(const uint4*)(igg + (wo + 2048u)); igR3 = *(const uint4*)(igg + (wo + 3072u)); \
                sgR0 = *(const uint4*)(sgg + wo); sgR1 = *(const uint4*)(sgg + (wo + 1024u)); sgR2 = *(const uint4*)(sgg + (wo + 2048u)); sgR3 = *(const uint4*)(sgg + (wo + 3072u)); \
                qa0 = *(const bf16x8*)(qdg + qo); qa1 = *(const bf16x8*)(qdg + (qo + 64u)); qa2 = *(const bf16x8*)(qdg + (qo + 128u)); qa3 = *(const bf16x8*)(qdg + (qo + 192u)); }
            P4_LOADS((size_t)(chunk * 4) * 32768)
#pragma unroll
            for (int hh = 0; hh < 4; ++hh) {
                {
                    const int sr = tid >> 4, sc = tid & 15, wr = lane >> 4, wc = (lane & 15) * 16;
                    *(uint4*)(smem + swz(sr, sc)) = stR0; *(uint4*)(smem + swz(sr + 32, sc)) = stR1;
                    *(uint4*)(smem + swz(sr + 64, sc)) = stR2; *(uint4*)(smem + swz(sr + 96, sc)) = stR3;
                    *(uint4*)(igs + wr * 272 + wc) = igR0; *(uint4*)(igs + (wr + 4) * 272 + wc) = igR1;
                    *(uint4*)(igs + (wr + 8) * 272 + wc) = igR2; *(uint4*)(igs + (wr + 12) * 272 + wc) = igR3;
                    *(uint4*)(sgs + wr * 272 + wc) = sgR0; *(uint4*)(sgs + (wr + 4) * 272 + wc) = sgR1;
                    *(uint4*)(sgs + (wr + 8) * 272 + wc) = sgR2; *(uint4*)(sgs + (wr + 12) * 272 + wc) = sgR3;
                }
                lds_barrier();
                bf16x8 qc[4];
                qc[0] = qa0; qc[1] = qa1; qc[2] = qa2; qc[3] = qa3;
                {
                    const int sct = hh * 512 + tid;
                    const float tv = *(const float*)((const char*)Yg + (unsigned)((sct >> 4) * 2048 + (sct & 15) * 64));
                    asm volatile("" :: "v"(tv));
                }
                P4_LOADS((size_t)(chunk * 4 + (hh < 3 ? hh + 1 : 3)) * 32768)
                f32x4 o[8];
#pragma unroll
                for (int nt = 0; nt < 8; ++nt) {
                    o[nt] = (f32x4){0.f, 0.f, 0.f, 0.f};
#pragma unroll
                    for (int ks = 0; ks < 4; ++ks) o[nt] = mfma16(qc[ks], frag(smem, nt, ks, fr, fq), o[nt]);
                }
#pragma unroll
                for (int nt = 0; nt < 8; ++nt)
#pragma unroll
                    for (int r = 0; r < 4; ++r) o[nt][r] += bf2f(*(const u16*)(igs + (fq * 4 + r) * 272 + (nt * 16 + fr) * 2));
                float gng[8];
#pragma unroll
                for (int nt = 0; nt < 8; ++nt) gng[nt] = p.gn_g[hh * 128 + nt * 16 + fr];
#pragma unroll
                for (int rp = 0; rp < 2; ++rp) {
                    float yv[2][8];
#pragma unroll
                    for (int r2 = 0; r2 < 2; ++r2) {
                        const int r = rp * 2 + r2;
                        float s = 0.f;
#pragma unroll
                        for (int nt = 0; nt < 8; ++nt) s += o[nt][r];
                        s = red16(s);
                        const float mean = s * (1.0f / 128.0f);
                        float q2 = 0.f;
#pragma unroll
                        for (int nt = 0; nt < 8; ++nt) { const float dv = o[nt][r] - mean; q2 += dv * dv; }
                        q2 = red16(q2);
                        const float rstd = rsqrtf(q2 * (1.0f / 128.0f) + 1e-6f);
#pragma unroll
                        for (int nt = 0; nt < 8; ++nt) {
                            const float gv = bf2f(*(const u16*)(sgs + (fq * 4 + r) * 272 + (nt * 16 + fr) * 2));
                            yv[r2][nt] = (o[nt][r] - mean) * rstd * gng[nt] * gv;
                        }
                    }
#pragma unroll
                    for (int nt = 0; nt < 8; ++nt)
                        *(uint32_t*)(ys + (fq * 4 + rp * 2 + odd) * 272 + (nt * 16 + (fr & ~1)) * 2) = pair_pack(yv[0][nt], yv[1][nt], odd);
                }
                asm volatile("s_waitcnt lgkmcnt(0)" ::: "memory");
                char* yo = (char*)(Yg + (size_t)(w * 16) * 1024 + 512 + hh * 128);
#pragma unroll
                for (int i = 0; i < 4; ++i) {
                    const int row = (lane >> 4) + 4 * i, ch = lane & 15;
                    *(uint4*)(yo + (unsigned)(row * 2048 + ch * 16)) = *(const uint4*)(ys + row * 272 + ch * 16);
                }
                lds_barrier();
            }
        }
        __threadfence_block();
        __syncthreads();
        float* part = (float*)(smem + SM_SMALL);
        float* rsv = (float*)(smem + 65536);
        f32x4 acc[8][4];
        char* outb = (char*)(p.out + (size_t)chunk * 128 * 1024 + w * 64);
        const char* xb = (const char*)(p.x + (size_t)chunk * 128 * 1024 + w * 64);
        const unsigned oo = (unsigned)(fq * 16384 + fr * 4);
        u16* Zg = (u16*)(p.ws + OFF_Z) + (size_t)chunk * 128 * 512;
#define ROWSQ(HF) \
        _Pragma("unroll") for (int mt = 0; mt < 8; ++mt) \
        _Pragma("unroll") for (int r = 0; r < 4; ++r) { \
            float s = 0.f; \
            _Pragma("unroll") for (int nt = 0; nt < 4; ++nt) s += acc[mt][nt][r] * acc[mt][nt][r]; \
            s = red16(s); \
            if (fr == 0) part[((HF) * 8 + w) * 128 + mt * 16 + fq * 4 + r] = s; \
        }
        {
            const bf16x8* Bf = (const bf16x8*)(p.ws + OFF_WOUTF) + ((size_t)(0 * 8 + w) * 128) * 64;
            gemm_core<4, true>(Yg, Bf, smem, acc, (const char*)(p.x + (size_t)chunk * 128 * 1024));
            ROWSQ(0)
            char* zb = (char*)(Zg + w * 64);
            const unsigned zo = (unsigned)((fq * 4 + odd) * 1024 + (fr & ~1) * 2);
#pragma unroll
            for (int mt = 0; mt < 8; ++mt) {
                char* zm = zb + mt * 16384;
#pragma unroll
                for (int nt = 0; nt < 4; ++nt)
#pragma unroll
                    for (int rp = 0; rp < 2; ++rp)
                        *(uint32_t*)(zm + (zo + (unsigned)(rp * 2048 + nt * 32))) = pair_pack(acc[mt][nt][rp * 2], acc[mt][nt][rp * 2 + 1], odd);
            }
        }
        {
            const bf16x8* Bf = (const bf16x8*)(p.ws + OFF_WOUTF) + ((size_t)(1 * 8 + w) * 128) * 64;
            gemm_core<4>(Yg, Bf, smem, acc);
            ROWSQ(1)
        }
        __syncthreads();
        if (tid < 128) {
            float s = 0.f;
#pragma unroll
            for (int k = 0; k < 16; ++k) s += part[k * 128 + tid];
            rsv[tid] = rsqrtf(s * (1.0f / 1024.0f) + 1e-6f);
        }
        lds_barrier();
        const float* gate = (const float*)(p.ws + OFF_MOD) + b * 3072 + 2048;
        {
            float gg[4];
#pragma unroll
            for (int nt = 0; nt < 4; ++nt) { const int col = 512 + w * 64 + nt * 16 + fr; gg[nt] = gate[col] * p.g_post[col]; }
            const int q = fr & 3, q1 = q & 1, q2 = q >> 1;
            const unsigned po = (unsigned)((fq * 4 + q) * 4096 + (fr & ~3) * 4);
#pragma unroll
            for (int mt = 0; mt < 8; ++mt) {
                float rs4[4];
#pragma unroll
                for (int r = 0; r < 4; ++r) rs4[r] = rsv[mt * 16 + fq * 4 + r];
                char* ob = outb + (mt * 16) * 4096 + 2048;
                const char* xr = xb + (mt * 16) * 4096 + 2048;
#pragma unroll
                for (int nt = 0; nt < 4; ++nt) {
                    float v[4];
#pragma unroll
                    for (int r = 0; r < 4; ++r) v[r] = gg[nt] * acc[mt][nt][r] * rs4[r];
                    const float ra = swap1(q1 ? v[0] : v[1]), rb = swap1(q1 ? v[2] : v[3]);
                    const float a0 = q1 ? ra : v[0], a1 = q1 ? v[1] : ra;
                    const float b0 = q1 ? rb : v[2], b1 = q1 ? v[3] : rb;
                    const float sa = swap2(q2 ? a0 : b0), sb = swap2(q2 ? a1 : b1);
                    float4 o;
                    o.x = q2 ? sa : a0; o.y = q2 ? sb : a1; o.z = q2 ? b0 : sa; o.w = q2 ? b1 : sb;
                    const float4 xv = *(const float4*)(xr + (po + (unsigned)(nt * 64)));
                    o.x += xv.x; o.y += xv.y; o.z += xv.z; o.w += xv.w;
                    *(float4*)(ob + (po + (unsigned)(nt * 64))) = o;
                }
            }
        }
        {
            const int c8 = (tid & 63) * 8, r0 = tid >> 6;
            float gq[8];
            {
                const float4 g0 = *(const float4*)(gate + c8), g1 = *(const float4*)(gate + c8 + 4);
                const float4 p0 = *(const float4*)(p.g_post + c8), p1 = *(const float4*)(p.g_post + c8 + 4);
                gq[0] = g0.x * p0.x; gq[1] = g0.y * p0.y; gq[2] = g0.z * p0.z; gq[3] = g0.w * p0.w;
                gq[4] = g1.x * p1.x; gq[5] = g1.y * p1.y; gq[6] = g1.z * p1.z; gq[7] = g1.w * p1.w;
            }
            char* ob = (char*)(p.out + (size_t)chunk * 128 * 1024);
            const char* xr = (const char*)(p.x + (size_t)chunk * 128 * 1024);
            const char* zr = (const char*)Zg;
            const unsigned vo = (unsigned)(r0 * 4096 + c8 * 4), vz = (unsigned)(r0 * 1024 + c8 * 2);
#pragma unroll 4
            for (int i = 0; i < 16; ++i) {
                const uint4 z = *(const uint4*)(zr + (vz + (unsigned)(i * 8192)));
                const float4 x0 = *(const float4*)(xr + (vo + (unsigned)(i * 32768)));
                const float4 x1 = *(const float4*)(xr + (vo + (unsigned)(i * 32768 + 16)));
                const float rs = rsv[i * 8 + r0];
                float4 o0, o1;
                o0.x = x0.x + gq[0] * bf2f((u16)(z.x & 0xffff)) * rs; o0.y = x0.y + gq[1] * bf2f((u16)(z.x >> 16)) * rs;
                o0.z = x0.z + gq[2] * bf2f((u16)(z.y & 0xffff)) * rs; o0.w = x0.w + gq[3] * bf2f((u16)(z.y >> 16)) * rs;
                o1.x = x1.x + gq[4] * bf2f((u16)(z.z & 0xffff)) * rs; o1.y = x1.y + gq[5] * bf2f((u16)(z.z >> 16)) * rs;
                o1.z = x1.z + gq[6] * bf2f((u16)(z.w & 0xffff)) * rs; o1.w = x1.w + gq[7] * bf2f((u16)(z.w >> 16)) * rs;
                *(float4*)(ob + (vo + (unsigned)(i * 32768))) = o0;
                *(float4*)(ob + (vo + (unsigned)(i * 32768 + 16))) = o1;
            }
        }
        lds_barrier();
    }
}

#ifndef N_LAUNCHES
#define N_LAUNCHES 1
#endif

#if N_LAUNCHES == 1
#define XB_CONV 64
__global__ void __launch_bounds__(NTHREADS) fwd(P p) {
    __shared__ __attribute__((aligned(16))) char smem[SM_TOTAL];
    const int bid = blockIdx.x, nb = gridDim.x;
    if (threadIdx.x == 0) *(uint4*)(smem + SM_BARW) = make_uint4(0u, 0u, 0u, 0u);
    __syncthreads();
    unsigned* barG = (unsigned*)(p.ws + OFF_BAR);
    XcdBarrier xb = xcd_barrier_post(barG, (volatile LAS unsigned*)(smem + SM_BARW), (unsigned)nb);
    if (nb == 256) {
        const int grp = bid >> 7, lb = bid & 127;
        XcdBarrier xl = xcd_barrier_post(barG + (1 + grp) * XCD_BAR_WORDS, (volatile LAS unsigned*)(smem + SM_BARW + 8), 128u);
        phase0(p, smem, bid, nb);
        xcd_barrier(xb);
        if (grp == 1) {
            phase0_conv(p, lb, 128);
            asm volatile("s_waitcnt vmcnt(0)" ::: "memory");
            __syncthreads();
            if (threadIdx.x == 0) {
                __builtin_amdgcn_fence(__ATOMIC_RELEASE, "agent");
                asm volatile("s_waitcnt vmcnt(0)" ::: "memory");
                (void)xb_add(&barG[XB_CONV], 1u);
            }
        }
        phase1(p, bid, nb);
        asm volatile("s_waitcnt vmcnt(0)" ::: "memory");
        __syncthreads();
        if (threadIdx.x == 0) {
            XB_SPIN(xb_ld(&barG[XB_CONV]) < 128u, barG);
            __builtin_amdgcn_fence(__ATOMIC_ACQUIRE, "agent");
            asm volatile("s_waitcnt vmcnt(0)" ::: "memory");
        }
        __syncthreads();
        phase2(p, smem, bid, nb);
        xcd_barrier(xl);
        phase3(p, lb, 128, grp * 32, 32);
        xcd_barrier(xl);
        phase45(p, smem, bid, nb);
    } else {
        phase0(p, smem, bid, nb);
        phase0_conv(p, bid, nb);
        xcd_barrier(xb);
        phase1(p, bid, nb);
        xcd_barrier(xb);
        phase2(p, smem, bid, nb);
        xcd_barrier(xb);
        phase3(p, bid, nb);
        xcd_barrier(xb);
        phase45(p, smem, bid, nb);
    }
}
#else
__global__ void __launch_bounds__(NTHREADS) k_phase0(P p) { __shared__ __attribute__((aligned(16))) char smem[SM_TOTAL]; phase0(p, smem, blockIdx.x, gridDim.x); phase0_conv(p, blockIdx.x, gridDim.x); }
__global__ void __launch_bounds__(NTHREADS) k_phase1(P p) { phase1(p, blockIdx.x, gridDim.x); }
__global__ void __launch_bounds__(NTHREADS) k_phase2(P p) { __shared__ __attribute__((aligned(16))) char smem[SM_TOTAL]; phase2(p, smem, blockIdx.x, gridDim.x); }
__global__ void __launch_bounds__(NTHREADS) k_phase3(P p) { phase3(p, blockIdx.x, gridDim.x); }
__global__ void __launch_bounds__(NTHREADS) k_phase45(P p) { __shared__ __attribute__((aligned(16))) char smem[SM_TOTAL]; phase45(p, smem, blockIdx.x, gridDim.x); }
#endif

extern "C" void kernel_launch(void* const* d_in, const int* in_sizes, int n_in, void* d_out, int out_size, void* d_ws, size_t ws_size,
                              hipStream_t stream) {
    P p{};
    p.x = (const float*)d_in[0]; p.c = (const float*)d_in[1]; p.pos = (const int*)d_in[2]; p.w_ada = (const float*)d_in[3];
    p.b_ada = (const float*)d_in[4]; p.g_pre = (const float*)d_in[5]; p.w_in = (const float*)d_in[6]; p.ln_g = (const float*)d_in[7];
    p.gws = (const float*)d_in[8]; p.gbs = (const float*)d_in[9]; p.gn_g = (const float*)d_in[10]; p.w_out = (const float*)d_in[11];
    p.g_post = (const float*)d_in[12]; p.out = (float*)d_out; p.ws = (char*)d_ws;
    p.ph_lo = 0; p.ph_hi = 5;
    static int grid = 0;
    if (!grid) { int dev = 0, cus = 0; if (hipGetDevice(&dev) == hipSuccess && hipDeviceGetAttribute(&cus, hipDeviceAttributeMultiprocessorCount, dev) == hipSuccess && cus > 0) grid = cus < 256 ? cus : 256; else grid = 256; }
#if N_LAUNCHES == 1
    (void)hipMemsetAsync((char*)d_ws + OFF_BAR, 0, OFF_MOD + 16 * 3072 * 4, stream);
    void* args[] = {&p};
    hipError_t e = hipLaunchCooperativeKernel((const void*)fwd, dim3(grid), dim3(NTHREADS), args, 0, stream);
    if (e != hipSuccess) fprintf(stderr, "cooperative launch failed: %s\n", hipGetErrorString(e));
#else
    hipLaunchKernelGGL(k_phase0, dim3(grid), dim3(NTHREADS), 0, stream, p);
    hipLaunchKernelGGL(k_phase1, dim3(grid), dim3(NTHREADS), 0, stream, p);
    hipLaunchKernelGGL(k_phase2, dim3(grid), dim3(NTHREADS), 0, stream, p);
    hipLaunchKernelGGL(k_phase3, dim3(grid), dim3(NTHREADS), 0, stream, p);
    hipLaunchKernelGGL(k_phase45, dim3(grid), dim3(NTHREADS), 0, stream, p);
#endif
}
```
